# Optimizing an MI355X kernel written in HIP

```python
import jax, jax.numpy as jnp
from jax import lax
import numpy as np

D_MODEL = 1024
BATCH = 4
SEQ = 4096
DEPTH = 4

N_MIXERS = 2
N_A = (DEPTH + 1) // 2
N_B = DEPTH // 2
LRU_WIDTH = D_MODEL
LRU_HEADS = 4
LRU_BLOCK = LRU_WIDTH // LRU_HEADS
RG_C = 8.0
CONV_WIDTH = 4
CONV_LEFT = 2
FOURIER_GROUPS = 4
FOURIER_GROUP_DIM = D_MODEL // FOURIER_GROUPS
N_EXPERTS = 16
CAPACITY_FACTOR = 2
EXPERT_FF = 2 * D_MODEL
PLE_DIM = 256
EPS = 1e-6

kernel_name = "hybrid_rglru_fnet_expert_choice_encoder"


def rms_norm(x, g):
    xf = x.astype(jnp.float32)
    y = xf * lax.rsqrt(jnp.mean(xf * xf, axis=-1, keepdims=True) + EPS)
    return (y * g.astype(jnp.float32)).astype(x.dtype)


def _lin_rec(left, right):
    a1, b1 = left
    a2, b2 = right
    return a1 * a2, a2 * b1 + b2


def rglru_mixer(xn, w_in, b_in, conv_w, conv_b, gx_w, gx_b, ga_w, ga_b, lam, w_out, b_out):
    B, S, _ = xn.shape
    proj = xn @ w_in + b_in
    gate, u = jnp.split(proj, 2, axis=-1)
    up = jnp.pad(u, ((0, 0), (CONV_LEFT, CONV_WIDTH - 1 - CONV_LEFT), (0, 0)))
    conv = up[:, 0:S] * conv_w[0]
    for k in range(1, CONV_WIDTH):
        conv = conv + up[:, k:k + S] * conv_w[k]
    uf = (conv + conv_b).astype(jnp.float32)
    ub = uf.reshape(B, S, LRU_HEADS, LRU_BLOCK)
    h_sum = jnp.zeros_like(uf)
    for d in range(2):
        i_t = jax.nn.sigmoid(jnp.einsum('bshi,hij->bshj', ub, gx_w[d].astype(jnp.float32))
                             + gx_b[d].astype(jnp.float32)).reshape(B, S, LRU_WIDTH)
        r_t = jax.nn.sigmoid(jnp.einsum('bshi,hij->bshj', ub, ga_w[d].astype(jnp.float32))
                             + ga_b[d].astype(jnp.float32)).reshape(B, S, LRU_WIDTH)
        log_a = -RG_C * r_t * jax.nn.softplus(-lam[d].astype(jnp.float32))
        a_t = jnp.exp(log_a)
        b_t = jnp.sqrt(-jnp.expm1(2.0 * log_a)) * (i_t * uf)
        _, h = lax.associative_scan(_lin_rec, (a_t, b_t), axis=1, reverse=(d == 1))
        h_sum = h_sum + h
    y = h_sum.astype(xn.dtype) * jax.nn.gelu(gate, approximate=True)
    return y @ w_out + b_out


def fourier_mixer(xn, w_in, w_out):
    B, S, D = xn.shape
    u = (xn @ w_in).reshape(B, S, FOURIER_GROUPS, FOURIER_GROUP_DIM).astype(jnp.float32)
    f = jnp.fft.fft2(u, axes=(1, 3), norm="ortho").real
    return f.reshape(B, S, D).astype(xn.dtype) @ w_out


def expert_choice_ffn(xn, w_router, w_gate, w_up, w_down):
    B, S, D = xn.shape
    cap = max(1, CAPACITY_FACTOR * S // N_EXPERTS)
    aff = jax.nn.softmax((xn @ w_router).astype(jnp.float32), axis=-1)
    gates, idx = lax.top_k(jnp.swapaxes(aff, 1, 2), cap)
    idx_flat = idx.reshape(B, N_EXPERTS * cap)
    xg = jnp.take_along_axis(xn, idx_flat[..., None], axis=1).reshape(B, N_EXPERTS, cap, D)
    hg = jax.nn.silu(jnp.einsum('becd,edf->becf', xg, w_gate)) * jnp.einsum('becd,edf->becf', xg, w_up)
    yg = jnp.einsum('becf,efd->becd', hg, w_down) * gates[..., None].astype(xn.dtype)
    out = jnp.zeros_like(xn).at[jnp.arange(B)[:, None], idx_flat].add(
        yg.reshape(B, N_EXPERTS * cap, D))
    return out


def setup_inputs(seed: int = 0) -> dict:
    key = jax.random.key(seed)
    ks = jax.random.split(key, 32)
    f32 = jnp.float32
    nrm = lambda k, shape, scale: jax.random.normal(k, shape, f32) * scale
    D, W = D_MODEL, LRU_WIDTH
    u_rad = jax.random.uniform(ks[10], (N_A, 2, W), f32, minval=0.9, maxval=0.999)
    s = u_rad ** (1.0 / RG_C)
    lam = jnp.log(s) - jnp.log1p(-s)
    return {
        "x": nrm(ks[0], (BATCH, SEQ, D), 1.0),
        "p": nrm(ks[1], (DEPTH, BATCH, SEQ, PLE_DIM), 1.0),
        "g_mix": 1.0 + nrm(ks[2], (DEPTH, D), 0.02),
        "g_ffn": 1.0 + nrm(ks[3], (DEPTH, D), 0.02),
        "g_ple": 1.0 + nrm(ks[4], (DEPTH, D), 0.02),
        "g_final": 1.0 + nrm(ks[5], (D,), 0.02),
        "rg_w_in": nrm(ks[6], (N_A, D, 2 * W), D ** -0.5),
        "rg_b_in": nrm(ks[7], (N_A, 2 * W), 0.01),
        "rg_conv_w": nrm(ks[8], (N_A, CONV_WIDTH, W), CONV_WIDTH ** -0.5),
        "rg_conv_b": nrm(ks[9], (N_A, W), 0.01),
        "rg_gx_w": nrm(ks[11], (N_A, 2, LRU_HEADS, LRU_BLOCK, LRU_BLOCK), LRU_BLOCK ** -0.5),
        "rg_gx_b": nrm(ks[12], (N_A, 2, LRU_HEADS, LRU_BLOCK), 0.01),
        "rg_ga_w": nrm(ks[13], (N_A, 2, LRU_HEADS, LRU_BLOCK, LRU_BLOCK), LRU_BLOCK ** -0.5),
        "rg_ga_b": nrm(ks[14], (N_A, 2, LRU_HEADS, LRU_BLOCK), 0.01),
        "rg_lam": lam,
        "rg_w_out": nrm(ks[15], (N_A, W, D), W ** -0.5),
        "rg_b_out": nrm(ks[16], (N_A, D), 0.01),
        "ft_w_in": nrm(ks[17], (N_B, D, D), D ** -0.5),
        "ft_w_out": nrm(ks[18], (N_B, D, D), D ** -0.5),
        "w_router": nrm(ks[19], (DEPTH, D, N_EXPERTS), D ** -0.5),
        "w_gate": nrm(ks[20], (DEPTH, N_EXPERTS, D, EXPERT_FF), D ** -0.5),
        "w_up": nrm(ks[21], (DEPTH, N_EXPERTS, D, EXPERT_FF), D ** -0.5),
        "w_down": nrm(ks[22], (DEPTH, N_EXPERTS, EXPERT_FF, D), EXPERT_FF ** -0.5),
        "ple_w_proj": nrm(ks[23], (DEPTH, PLE_DIM, D), PLE_DIM ** -0.5),
        "ple_w_gate": nrm(ks[24], (DEPTH, D, D), D ** -0.5),
    }


def reference(x, p, g_mix, g_ffn, g_ple, g_final, rg_w_in, rg_b_in, rg_conv_w, rg_conv_b,
              rg_gx_w, rg_gx_b, rg_ga_w, rg_ga_b, rg_lam, rg_w_out, rg_b_out,
              ft_w_in, ft_w_out, w_router, w_gate, w_up, w_down, ple_w_proj, ple_w_gate):
    h = x
    for i in range(DEPTH):
        xn = rms_norm(h, g_mix[i])
        j = i // N_MIXERS
        if i % N_MIXERS == 0:
            mix = rglru_mixer(xn, rg_w_in[j], rg_b_in[j], rg_conv_w[j], rg_conv_b[j],
                              rg_gx_w[j], rg_gx_b[j], rg_ga_w[j], rg_ga_b[j], rg_lam[j],
                              rg_w_out[j], rg_b_out[j])
        else:
            mix = fourier_mixer(xn, ft_w_in[j], ft_w_out[j])
        h = h + mix
        h = h + expert_choice_ffn(rms_norm(h, g_ffn[i]), w_router[i], w_gate[i], w_up[i], w_down[i])
        gate = jax.nn.sigmoid(rms_norm(h, g_ple[i]) @ ple_w_gate[i])
        h = h + gate * (p[i] @ ple_w_proj[i])
    return rms_norm(h, g_final)
```

```cpp
#include <hip/hip_runtime.h>
#include <cstdio>
#include <cstdint>

#ifndef MK_ONE_LAUNCH
#define MK_ONE_LAUNCH 1
#endif

#define LAS __attribute__((address_space(3)))
typedef unsigned short bf16;
typedef short bf16x8 __attribute__((ext_vector_type(8)));
typedef float f32x4 __attribute__((ext_vector_type(4)));
typedef float f32x2 __attribute__((ext_vector_type(2)));
typedef unsigned u32x2 __attribute__((ext_vector_type(2)));
typedef unsigned u32x4 __attribute__((ext_vector_type(4)));

constexpr int NB = 4, S = 4096, D = 1024, T = NB * S, DEPTH = 4, NE = 16, CAP = 512, FF = 2048, PLE = 256, NSLOT = NE * NB * CAP;
constexpr float EPS = 1e-6f;
constexpr int KH = 2176;
constexpr int KSEQ = 2 * KH;
constexpr int NWAVES = 8, NTHREADS = 512;

constexpr size_t MiB = 1u << 20;
constexpr size_t WS_CTL = 0, CTL_ZERO_BYTES = 1 * MiB;
constexpr size_t WS_W1T = 1 * MiB;
constexpr size_t WS_W2T = WS_W1T + 256 * MiB;
constexpr size_t WS_WINT = WS_W2T + 128 * MiB;
constexpr size_t WS_GATET = WS_WINT + 8 * MiB;
constexpr size_t WS_WOUTT = WS_GATET + 4 * MiB;
constexpr size_t WS_FTINT = WS_WOUTT + 4 * MiB;
constexpr size_t WS_FTOUTT = WS_FTINT + 4 * MiB;
constexpr size_t WS_PLEGT = WS_FTOUTT + 4 * MiB;
constexpr size_t WS_PLEPT = WS_PLEGT + 8 * MiB;
constexpr size_t WS_DFTC = WS_PLEPT + 2 * MiB;
constexpr size_t WS_DFTS = WS_DFTC + 1 * MiB;
constexpr size_t WS_PBF = WS_DFTS + 64 * MiB;
constexpr size_t WS_H = WS_PBF + 32 * MiB;
constexpr size_t WS_XN = WS_H + 64 * MiB;
constexpr size_t WS_BUFA = WS_XN + 32 * MiB;
constexpr size_t WS_BUFB = WS_BUFA + 32 * MiB;
constexpr size_t WS_BUFC = WS_BUFB + 32 * MiB;
constexpr size_t WS_LA = WS_BUFC + 32 * MiB;
constexpr size_t WS_BB = WS_LA + 64 * MiB;
constexpr size_t WS_Y = WS_BB + 64 * MiB;
constexpr size_t WS_CA = WS_Y + 32 * MiB;
constexpr size_t WS_CB = WS_CA + 2 * MiB;
constexpr size_t WS_AFF = WS_CB + 2 * MiB;
constexpr size_t WS_IDX = WS_AFF + 1 * MiB;
constexpr size_t WS_GATEV = WS_IDX + 1 * MiB;
constexpr size_t WS_SLOTOF = WS_GATEV + 1 * MiB;
constexpr size_t WS_XG = WS_SLOTOF + 1 * MiB;
constexpr size_t WS_HG = WS_XG + 64 * MiB;
constexpr size_t WS_YG = WS_HG + 128 * MiB;
constexpr size_t WS_PP = WS_YG + 64 * MiB;
constexpr size_t WS_HB = WS_PP + 128 * MiB;
constexpr size_t WS_SSQ = WS_HB + 32 * MiB;
constexpr size_t WS_END = WS_SSQ + 1 * MiB;

constexpr int CW_BAR = 4096;

constexpr int RING_BYTES = 131072;
constexpr int MISC_OFF = RING_BYTES;
constexpr int LDS_BYTES = 147456;

__device__ __forceinline__ unsigned cvt_pk_bf16(float lo, float hi) { unsigned r; asm("v_cvt_pk_bf16_f32 %0, %1, %2" : "=v"(r) : "v"(lo), "v"(hi)); return r; }
__device__ __forceinline__ float bf_lo(unsigned w) { return __uint_as_float(w << 16); }
__device__ __forceinline__ float bf_hi(unsigned w) { return __uint_as_float(w & 0xffff0000u); }
__device__ __forceinline__ float wave_sum(float v) {
#pragma unroll
    for (int o = 1; o < 64; o <<= 1) v += __shfl_xor(v, o);
    return v;
}
__device__ __forceinline__ float sigmoidf_(float x) { return __builtin_amdgcn_rcpf(1.f + __expf(-x)); }
constexpr float L2E = 1.4426950408889634f;
__device__ __forceinline__ float gelu_tanh(float x) {
    const float C0 = 2.f * 0.7978845608028654f * L2E, C1 = 2.f * 0.7978845608028654f * 0.044715f * L2E;
    const float e = __builtin_amdgcn_exp2f(x * __builtin_fmaf(x * x, C1, C0));
    return __builtin_fmaf(-x, __builtin_amdgcn_rcpf(1.f + e), x);
}
__device__ __forceinline__ unsigned pk4_fp8(float a, float b, float c, float d) { int w = 0; w = __builtin_amdgcn_cvt_pk_fp8_f32(a, b, w, false); w = __builtin_amdgcn_cvt_pk_fp8_f32(c, d, w, true); return (unsigned)w; }
__device__ __forceinline__ float clamp448(float x) { return __builtin_amdgcn_fmed3f(x, -448.f, 448.f); }
#define VM_WAIT() asm volatile("s_waitcnt vmcnt(0)" ::: "memory")
#define LDS_WAIT() asm volatile("s_waitcnt lgkmcnt(0)" ::: "memory")

#define XB_TMO      128
#define XB_XCNT(j)  (256  + 64 * (j))
#define XB_XSUB(j)  (1280 + 64 * (j))
#define XB_XGEN(j)  (2304 + 64 * (j))
#define XB_TOP      3328
#define XB_TOPGEN   3392
#define XCD_BAR_WORDS 3456
#define XB_SPIN_CAP (1u << 18)

__device__ __forceinline__ unsigned xb_ld(unsigned* p)              { return __hip_atomic_load(p, __ATOMIC_RELAXED, __HIP_MEMORY_SCOPE_AGENT); }
__device__ __forceinline__ unsigned xb_add(unsigned* p, unsigned v) { return __hip_atomic_fetch_add(p, v, __ATOMIC_RELAXED, __HIP_MEMORY_SCOPE_AGENT); }
__device__ __forceinline__ unsigned xb_xcc_id() { return (unsigned)__builtin_amdgcn_s_getreg((3 << 11) | 20) & 0xFu; }
#define XB_SPIN(cond, bar) do { unsigned _sp = 0; while (cond) { __builtin_amdgcn_s_sleep(1); \
    if ((++_sp & 255u) == 0u) { if (xb_ld(&(bar)[XB_TMO])) break; if (_sp > XB_SPIN_CAP) { atomicAdd(&(bar)[XB_TMO], 1u); break; } } } } while (0)

struct XcdBarrier { unsigned* bar; unsigned x; volatile LAS unsigned* st; };

__device__ __forceinline__ XcdBarrier xcd_barrier_post(unsigned* bar, volatile LAS unsigned* st) {
    XcdBarrier b; b.bar = bar; b.x = xb_xcc_id(); b.st = st;
    if (threadIdx.x == 0) (void)xb_add(&bar[XB_XCNT(b.x)], 1u);
    return b;
}
__device__ __forceinline__ void xcd_barrier_complete(unsigned* bar, unsigned x, unsigned& nloc, unsigned& nx) {
    const unsigned G = gridDim.x * gridDim.y * gridDim.z;
    unsigned sum, cnt, mine, sp = 0u;
    for (;;) {
        sum = 0u; cnt = 0u; mine = 0u;
#pragma unroll
        for (unsigned j = 0; j < 16; ++j) { const unsigned c = xb_ld(&bar[XB_XCNT(j)]); sum += c; cnt += (c > 0u) ? 1u : 0u; mine = (j == x) ? c : mine; }
        if (sum == G) break;
        __builtin_amdgcn_s_sleep(1);
        if ((++sp & 255u) == 0u) { if (xb_ld(&bar[XB_TMO])) break; if (sp > XB_SPIN_CAP) { atomicAdd(&bar[XB_TMO], 1u); break; } }
    }
    nloc = mine > 0u ? mine : 1u; nx = cnt > 0u ? cnt : 1u;
}
__device__ __forceinline__ void xcd_barrier(const XcdBarrier& b) {
    asm volatile("s_waitcnt vmcnt(0)" ::: "memory");
    __syncthreads();
    if (threadIdx.x == 0) {
        unsigned* bar = b.bar;
        __builtin_amdgcn_s_waitcnt(0);
        unsigned nloc = b.st[0], nx = b.st[1];
        if (nloc == 0u) { xcd_barrier_complete(bar, b.x, nloc, nx); b.st[0] = nloc; b.st[1] = nx; }
        const unsigned old = xb_add(&bar[XB_XSUB(b.x)], 1u);
        const unsigned gen = old / nloc;
        if (old + 1u == (gen + 1u) * nloc) {
            __builtin_amdgcn_fence(__ATOMIC_RELEASE, "agent");
            asm volatile("s_waitcnt vmcnt(0)" ::: "memory");
            const unsigned og = xb_add(&bar[XB_TOP], 1u);
            const unsigned tg = og / nx;
            if (og + 1u == (tg + 1u) * nx) xb_add(&bar[XB_TOPGEN], 1u);
            else XB_SPIN(xb_ld(&bar[XB_TOPGEN]) == tg, bar);
            __builtin_amdgcn_fence(__ATOMIC_ACQUIRE, "agent");
            xb_add(&bar[XB_XGEN(b.x)], 1u);
            asm volatile("s_waitcnt vmcnt(0)" ::: "memory");
        } else {
            __builtin_amdgcn_fence(__ATOMIC_ACQUIRE, "agent");
            XB_SPIN(xb_ld(&bar[XB_XGEN(b.x)]) == gen, bar);
            asm volatile("s_waitcnt vmcnt(0)" ::: "memory");
        }
    }
    __syncthreads();
}

constexpr int CW_GRP = 16384, CW_XID = 20480;
__device__ __forceinline__ void group_barrier(unsigned* ctl, int group, unsigned target, volatile LAS unsigned* st) {
    asm volatile("s_waitcnt vmcnt(0)" ::: "memory");
    __syncthreads();
    if (threadIdx.x == 0) {
        unsigned* c = ctl + CW_GRP + group * 16; unsigned* bar = ctl + CW_BAR;
        unsigned same = st[0];
        if (same == 0u) { unsigned* xi = ctl + CW_XID + group * 4; const unsigned i0 = xb_ld(xi), i1 = xb_ld(xi + 1), i2 = xb_ld(xi + 2), i3 = xb_ld(xi + 3); same = (i0 != 0u && i0 == i1 && i0 == i2 && i0 == i3) ? 2u : 1u; st[0] = same; }
        if (same == 2u) __builtin_amdgcn_fence(__ATOMIC_RELEASE, "workgroup"); else __builtin_amdgcn_fence(__ATOMIC_RELEASE, "agent");
        asm volatile("s_waitcnt vmcnt(0)" ::: "memory");
        (void)xb_add(c, 1u);
        __builtin_amdgcn_fence(__ATOMIC_ACQUIRE, "agent");
        XB_SPIN(xb_ld(c) < target, bar);
        asm volatile("s_waitcnt vmcnt(0)" ::: "memory");
    }
    __syncthreads();
}

namespace g8 {
constexpr int BM = 256, BK = 64, HALF = 128, HTB = HALF * BK * 2, STAGE_BYTES = 8 * HTB;
__device__ __forceinline__ int lds_byte(int r, int c) { const int st = (r >> 4) * 2 + (c >> 5), rr = r & 15, cc = c & 31, ob = rr * 64 + cc * 2; return st * 1024 + (ob ^ (((ob >> 9) & 1) << 5)); }
__device__ __forceinline__ int perm32(int rho) { const int n = rho >> 4, i = rho & 15; return 8 * (i >> 2) + 4 * n + (i & 3); }
__device__ __forceinline__ void stage_rc(int b, int& R, int& C) { const int st = b / 1024, sb = b % 1024, swz = sb ^ (((sb >> 9) & 1) << 5); R = (st >> 1) * 16 + swz / 64; C = (st & 1) * 32 + (swz % 64) / 2; }

enum Kind { K_RGIN = 0, K_RGGATE, K_RESID, K_PLAIN, K_FTCH, K_FTSEQ, K_FFN1, K_FFN2, K_PLE, K_PP };
struct Desc {
    int kind, K, lda, ldb, nM, nN, ldo, esz;
    const int* gidx;
    int u0, ustride;
    int grp;
    int sc_w, sc_a;
    const void* A; const void* Bt;
    void* o0; void* o1;
    const void* p0; const void* p1; const void* p2;
};
struct Tile { const char* a; const char* b; int pm, pn; };

__device__ __forceinline__ bool get_tile(const Desc& d, int i, Tile& t) {
    const int nunits = d.nM * d.nN;
    int pm, pn;
    if (d.grp) { const int bx = d.u0, v = (bx & 7) * 32 + (bx >> 3), q4 = d.nN >> 2, lg = q4 >> 1;
        if (i >= q4 * (d.nM >> 6)) return false;
        pm = (v >> 2) + 64 * (i >> lg); pn = (v & 3) + 4 * (i & (q4 - 1)); }
    else {
    const long L = (long)i * d.ustride + d.u0; if (d.u0 < 0 || L >= nunits) return false;
    int w = (int)L; { const int q = nunits / 8, r = nunits % 8, xcd = w % 8, off = w / 8; w = (xcd < r ? xcd * (q + 1) : r * (q + 1) + (xcd - r) * q) + off; }
    const int nig = 8 * d.nN, gid = w / nig, fm = gid * 8, gsz = (d.nM - fm) < 8 ? (d.nM - fm) : 8;
    pm = fm + ((w % nig) % gsz); pn = (w % nig) / gsz; }
    t.pm = pm; t.pn = pn;
    size_t arow = (size_t)pm * 256, acol = 0, brow = (size_t)pn * 256, bcol = 0;
    switch (d.kind) {
        case K_RGGATE: acol = (size_t)(pn >> 2) * 256; break;
        case K_FTCH:   arow = (size_t)(pm & 1) * 256; brow = ((size_t)(pm >> 3) * 2 + (pm & 1)) * 2048 + (size_t)pn * 256; bcol = (size_t)((pm >> 1) & 3) * 256; break;
        case K_FTSEQ:  arow = (size_t)(pm & 15) * 256; brow = (size_t)(pm >> 4) * 1024 + (size_t)pn * 256; bcol = ((pm & 15) >= 8) ? (size_t)KH : 0; break;
        case K_FFN1:   brow = (size_t)(pm >> 3) * 4096 + (size_t)pn * 256; break;
        case K_FFN2:   brow = (size_t)(pm >> 3) * 1024 + (size_t)pn * 256; break;
        case K_PP:     brow = (size_t)(pm >> 6) * 1024 + (size_t)pn * 256; break;
        default: break;
    }
    t.a = (const char*)d.A + (arow * d.lda + acol) * d.esz; t.b = (const char*)d.Bt + (brow * d.ldb + bcol) * d.esz;
    return true;
}

typedef f32x4 Acc[2][2][4][2];
__device__ __forceinline__ void load_bf16x8(const bf16* p, f32x4& v0, f32x4& v1) { const u32x4 w = *(const u32x4*)p; v0 = (f32x4){bf_lo(w.x), bf_hi(w.x), bf_lo(w.y), bf_hi(w.y)}; v1 = (f32x4){bf_lo(w.z), bf_hi(w.z), bf_lo(w.w), bf_hi(w.w)}; }
__device__ __forceinline__ void store_bf16x8(bf16* p, const f32x4 v0, const f32x4 v1) { u32x4 w; w.x = cvt_pk_bf16(v0[0], v0[1]); w.y = cvt_pk_bf16(v0[2], v0[3]); w.z = cvt_pk_bf16(v1[0], v1[1]); w.w = cvt_pk_bf16(v1[2], v1[3]); *(u32x4*)p = w; }
__device__ __forceinline__ void stg16_wt(void* p, const u32x4 w) { asm volatile("global_store_dwordx4 %0, %1, off sc1\n\ts_nop 1" :: "v"(p), "v"(w) : "memory"); }
__device__ __forceinline__ void stg8_wt(void* p, const u32x2 w) { asm volatile("global_store_dwordx2 %0, %1, off sc1" :: "v"(p), "v"(w) : "memory"); }
__device__ __forceinline__ void store_bf16x8_wt(bf16* p, const f32x4 v0, const f32x4 v1) { u32x4 w; w.x = cvt_pk_bf16(v0[0], v0[1]); w.y = cvt_pk_bf16(v0[2], v0[3]); w.z = cvt_pk_bf16(v1[0], v1[1]); w.w = cvt_pk_bf16(v1[2], v1[3]); stg16_wt(p, w); }
__device__ __forceinline__ void store_bf16x4(bf16* p, const f32x4 v) { u32x2 w; w.x = cvt_pk_bf16(v[0], v[1]); w.y = cvt_pk_bf16(v[2], v[3]); *(u32x2*)p = w; }

__device__ __forceinline__ void rows_rs(const float* ssq, int row0, int fq, float (&rs)[2][4]) {
    f32x4 p[2][4];
#pragma unroll
    for (int ai = 0; ai < 2; ++ai)
#pragma unroll
        for (int m = 0; m < 4; ++m) p[ai][m] = *(const f32x4*)(ssq + (size_t)(row0 + ai * 128 + m * 16) * 16 + 4 * fq);
#pragma unroll
    for (int ai = 0; ai < 2; ++ai)
#pragma unroll
        for (int m = 0; m < 4; ++m) { float s = (p[ai][m][0] + p[ai][m][1]) + (p[ai][m][2] + p[ai][m][3]); s += __shfl_xor(s, 16); s += __shfl_xor(s, 32); rs[ai][m] = rsqrtf(s * (1.f / D) + EPS); }
}
#define EPI_FP8_CASES \
    case K_FFN1: { \
        unsigned char* O = (unsigned char*)d.o0 + (size_t)(u.pm * 256 + lr0) * FF + u.pn * 128 + lc0; \
_Pragma("unroll") \
        for (int ai = 0; ai < 2; ++ai) \
_Pragma("unroll") \
            for (int m = 0; m < 4; ++m) \
                { u32x2 w8; \
_Pragma("unroll") \
                for (int n = 0; n < 2; ++n) { const f32x4 g = acc[ai][0][m][n], up = acc[ai][1][m][n]; f32x4 o; \
_Pragma("unroll") \
                    for (int j = 0; j < 4; ++j) o[j] = clamp448((g[j] * up[j]) * __builtin_amdgcn_rcpf(1.f + __builtin_amdgcn_exp2f(g[j]))); \
                    if (n == 0) w8.x = pk4_fp8(o[0], o[1], o[2], o[3]); else w8.y = pk4_fp8(o[0], o[1], o[2], o[3]); } \
                *(u32x2*)(O + (size_t)(ai * 128 + m * 16) * FF) = w8; } \
    } break; \
    case K_FFN2: { \
        const int row0 = u.pm * 256 + lr0; const float* gatev = (const float*)d.p0; unsigned char* O = (unsigned char*)d.o0 + (size_t)row0 * D + u.pn * 256 + lc0; \
        float gv[2][4]; \
_Pragma("unroll") \
        for (int ai = 0; ai < 2; ++ai) \
_Pragma("unroll") \
            for (int m = 0; m < 4; ++m) gv[ai][m] = gatev[row0 + ai * 128 + m * 16]; \
        asm volatile("" : "+v"(gv[0][0]), "+v"(gv[0][1]), "+v"(gv[0][2]), "+v"(gv[0][3]), "+v"(gv[1][0]), "+v"(gv[1][1]), "+v"(gv[1][2]), "+v"(gv[1][3])); \
_Pragma("unroll") \
        for (int ai = 0; ai < 2; ++ai) \
_Pragma("unroll") \
            for (int m = 0; m < 4; ++m) gv[ai][m] *= 64.f; \
_Pragma("unroll") \
        for (int ai = 0; ai < 2; ++ai) \
_Pragma("unroll") \
            for (int m = 0; m < 4; ++m) \
_Pragma("unroll") \
                for (int bj = 0; bj < 2; ++bj) { const f32x4 y0 = acc[ai][bj][m][0] * gv[ai][m], y1 = acc[ai][bj][m][1] * gv[ai][m]; u32x2 w8; \
                    w8.x = pk4_fp8(clamp448(y0[0]), clamp448(y0[1]), clamp448(y0[2]), clamp448(y0[3])); w8.y = pk4_fp8(clamp448(y1[0]), clamp448(y1[1]), clamp448(y1[2]), clamp448(y1[3])); \
                    stg8_wt(O + (size_t)(ai * 128 + m * 16) * D + bj * 128, w8); } \
    } break; \
    case K_PLE: { \
        const size_t o0 = (size_t)(u.pm * 256 + lr0) * D + u.pn * 256 + lc0; bf16* H = (bf16*)d.o0; const bf16* PP = (const bf16*)d.p0; float* ssq = (float*)d.p1; \
_Pragma("unroll") \
        for (int ai = 0; ai < 2; ++ai) \
_Pragma("unroll") \
            for (int mp = 0; mp < 2; ++mp) { u32x4 hw[2][2], pw[2][2]; \
_Pragma("unroll") \
              for (int mm = 0; mm < 2; ++mm) \
_Pragma("unroll") \
                for (int bj = 0; bj < 2; ++bj) { const size_t ro = o0 + (size_t)(ai * 128 + (2 * mp + mm) * 16) * D + bj * 128; hw[mm][bj] = *(const u32x4*)(H + ro); pw[mm][bj] = *(const u32x4*)(PP + ro); } \
              asm volatile("" : "+v"(hw[0][0]), "+v"(hw[0][1]), "+v"(hw[1][0]), "+v"(hw[1][1]), "+v"(pw[0][0]), "+v"(pw[0][1]), "+v"(pw[1][0]), "+v"(pw[1][1])); \
_Pragma("unroll") \
              for (int mm = 0; mm < 2; ++mm) { const int m = 2 * mp + mm; \
                float part = 0.f; \
_Pragma("unroll") \
                for (int bj = 0; bj < 2; ++bj) { const size_t ro = o0 + (size_t)(ai * 128 + m * 16) * D + bj * 128; const f32x4 a0 = acc[ai][bj][m][0], a1 = acc[ai][bj][m][1]; const u32x4 hh = hw[mm][bj], pp = pw[mm][bj]; f32x4 h0, h1; \
                    h0[0] = bf_lo(hh.x) + sigmoidf_(a0[0]) * bf_lo(pp.x); h0[1] = bf_hi(hh.x) + sigmoidf_(a0[1]) * bf_hi(pp.x); h0[2] = bf_lo(hh.y) + sigmoidf_(a0[2]) * bf_lo(pp.y); h0[3] = bf_hi(hh.y) + sigmoidf_(a0[3]) * bf_hi(pp.y); \
                    h1[0] = bf_lo(hh.z) + sigmoidf_(a1[0]) * bf_lo(pp.z); h1[1] = bf_hi(hh.z) + sigmoidf_(a1[1]) * bf_hi(pp.z); h1[2] = bf_lo(hh.w) + sigmoidf_(a1[2]) * bf_lo(pp.w); h1[3] = bf_hi(hh.w) + sigmoidf_(a1[3]) * bf_hi(pp.w); \
                    store_bf16x8(H + ro, h0, h1); part += ((h0[0] * h0[0] + h0[1] * h0[1]) + (h0[2] * h0[2] + h0[3] * h0[3])) + ((h1[0] * h1[0] + h1[1] * h1[1]) + (h1[2] * h1[2] + h1[3] * h1[3])); } \
                part += __shfl_xor(part, 16); part += __shfl_xor(part, 32); \
                if (fq == 0) ssq[(size_t)(u.pm * 256 + lr0 + ai * 128 + m * 16) * 16 + u.pn * 4 + wc] = part; } } \
    } break;

template <bool FP8>
__device__ __forceinline__ void epilogue(const Desc& d, const Acc& acc, const Tile& u) {
    int tz = threadIdx.x; asm volatile("" : "+v"(tz));
    const int wid = tz >> 6, lane = tz & 63, wr = wid >> 2, wc = wid & 3, fr = lane & 15, fq = lane >> 4;
    const int lr0 = wr * 64 + fr, lc0 = wc * 32 + 8 * fq;
    if constexpr (FP8) {
    switch (d.kind) {
    EPI_FP8_CASES
    default: break;
    }
    } else {
    switch (d.kind) {
    case K_RGIN: {
        const int row0 = u.pm * 256 + lr0, col0 = u.pn * 256 + lc0; const bool isg = u.pn < 4;
        bf16* O = isg ? (bf16*)d.o0 : (bf16*)d.o1; const int oc0 = isg ? col0 : col0 - 1024; const float* bias = (const float*)d.p0; const float* ssq = (const float*)d.p1;
        float rs[2][4]; f32x4 bv[2][2];
        rows_rs(ssq, row0, fq, rs);
#pragma unroll
        for (int bj = 0; bj < 2; ++bj)
#pragma unroll
            for (int n = 0; n < 2; ++n) bv[bj][n] = *(const f32x4*)(bias + col0 + bj * 128 + n * 4);
#pragma unroll
        for (int ai = 0; ai < 2; ++ai)
#pragma unroll
            for (int m = 0; m < 4; ++m)
#pragma unroll
                for (int bj = 0; bj < 2; ++bj) { f32x4 v[2];
#pragma unroll
                    for (int n = 0; n < 2; ++n) { v[n] = acc[ai][bj][m][n] * rs[ai][m] + bv[bj][n];
                        if (isg) { v[n][0] = gelu_tanh(v[n][0]); v[n][1] = gelu_tanh(v[n][1]); v[n][2] = gelu_tanh(v[n][2]); v[n][3] = gelu_tanh(v[n][3]); } }
                    store_bf16x8_wt(O + (size_t)(row0 + ai * 128 + m * 16) * D + oc0 + bj * 128, v[0], v[1]); }
    } break;
    case K_RGGATE: {
        const int head = u.pn >> 2, q = u.pn & 3, dr = q >> 1, c2 = q & 1;
        const int row0 = u.pm * 256 + lr0, ch0 = head * 256 + c2 * 128 + lc0;
        const float* gxb = (const float*)d.p0 + dr * 1024; const float* gab = (const float*)d.p1 + dr * 1024; const float* lam = (const float*)d.p2 + dr * 1024;
        bf16* la = (bf16*)d.o0 + (size_t)dr * T * D; bf16* bb = (bf16*)d.o1 + (size_t)dr * T * D; const bf16* UF = (const bf16*)d.A;
        f32x4 nbx[2], nba[2], sp[2], sp2[2];
#pragma unroll
        for (int n = 0; n < 2; ++n) { const f32x4 bx = *(const f32x4*)(gxb + ch0 + 4 * n), ba = *(const f32x4*)(gab + ch0 + 4 * n), lm = *(const f32x4*)(lam + ch0 + 4 * n);
#pragma unroll
            for (int j = 0; j < 4; ++j) { const float y = __expf(-lm[j]); sp[n][j] = -8.f * ((y < 0.03f) ? y * (1.f + y * (-0.5f + y * ((1.f / 3.f) - 0.25f * y))) : logf(1.f + y));
                sp2[n][j] = 2.f * L2E * sp[n][j]; nbx[n][j] = -L2E * bx[j]; nba[n][j] = -L2E * ba[j]; } }
#pragma unroll
        for (int ai = 0; ai < 2; ++ai) { u32x4 uw[4];
#pragma unroll
            for (int m = 0; m < 4; ++m) uw[m] = *(const u32x4*)(UF + (size_t)(row0 + ai * 128 + m * 16) * D + ch0);
#pragma unroll
            for (int m = 0; m < 4; ++m) { const size_t ro = (size_t)(row0 + ai * 128 + m * 16) * D + ch0;
                const float uf[2][4] = {{bf_lo(uw[m].x), bf_hi(uw[m].x), bf_lo(uw[m].y), bf_hi(uw[m].y)}, {bf_lo(uw[m].z), bf_hi(uw[m].z), bf_lo(uw[m].w), bf_hi(uw[m].w)}};
                f32x4 lo[2], bo[2];
#pragma unroll
                for (int n = 0; n < 2; ++n)
#pragma unroll
                    for (int j = 0; j < 4; ++j) {
                        const float it = __builtin_amdgcn_rcpf(1.f + __builtin_amdgcn_exp2f(__builtin_fmaf(acc[ai][0][m][n][j], -L2E, nbx[n][j])));
                        const float rt = __builtin_amdgcn_rcpf(1.f + __builtin_amdgcn_exp2f(__builtin_fmaf(acc[ai][1][m][n][j], -L2E, nba[n][j])));
                        const float em = 1.f - __builtin_amdgcn_exp2f(sp2[n][j] * rt);
                        lo[n][j] = sp[n][j] * rt; bo[n][j] = __builtin_amdgcn_sqrtf(em) * (it * uf[n][j]); }
                store_bf16x8_wt(la + ro, lo[0], lo[1]); store_bf16x8_wt(bb + ro, bo[0], bo[1]); } }
    } break;
    case K_RESID: {
        const int row0 = u.pm * 256 + lr0, col0 = u.pn * 256 + lc0; bf16* H = (bf16*)d.o0; const float* bias = (const float*)d.p0;
        f32x4 bv[2][2];
#pragma unroll
        for (int bj = 0; bj < 2; ++bj)
#pragma unroll
            for (int n = 0; n < 2; ++n) bv[bj][n] = bias ? *(const f32x4*)(bias + col0 + bj * 128 + n * 4) : (f32x4){0.f, 0.f, 0.f, 0.f};
#pragma unroll
        for (int ai = 0; ai < 2; ++ai) { u32x4 hw[4][2];
#pragma unroll
            for (int m = 0; m < 4; ++m)
#pragma unroll
                for (int bj = 0; bj < 2; ++bj) hw[m][bj] = *(const u32x4*)(H + (size_t)(row0 + ai * 128 + m * 16) * D + col0 + bj * 128);
            asm volatile("" : "+v"(hw[0][0]), "+v"(hw[0][1]), "+v"(hw[1][0]), "+v"(hw[1][1]), "+v"(hw[2][0]), "+v"(hw[2][1]), "+v"(hw[3][0]), "+v"(hw[3][1]));
#pragma unroll
            for (int m = 0; m < 4; ++m)
#pragma unroll
                for (int bj = 0; bj < 2; ++bj) { const u32x4 w = hw[m][bj]; const f32x4 h0 = {bf_lo(w.x), bf_hi(w.x), bf_lo(w.y), bf_hi(w.y)}, h1 = {bf_lo(w.z), bf_hi(w.z), bf_lo(w.w), bf_hi(w.w)};
                    store_bf16x8_wt(H + (size_t)(row0 + ai * 128 + m * 16) * D + col0 + bj * 128, h0 + acc[ai][bj][m][0] + bv[bj][0], h1 + acc[ai][bj][m][1] + bv[bj][1]); } }
    } break;
    case K_PLAIN: case K_FTCH: case K_FTSEQ: case K_PP: {
        int orow = u.pm * 256, ocol = u.pn * 256;
        if (d.kind == K_FTCH) { orow = (u.pm >> 1) * 256; ocol = (u.pm & 1) * KH + u.pn * 256; }
        bf16* O = (bf16*)d.o0 + (size_t)(orow + lr0) * d.ldo + ocol + lc0; const float* ssq = (const float*)d.p0;
        float rs[2][4];
        if (ssq) rows_rs(ssq, orow + lr0, fq, rs);
        else {
#pragma unroll
            for (int ai = 0; ai < 2; ++ai)
#pragma unroll
                for (int m = 0; m < 4; ++m) rs[ai][m] = 1.f; }
#pragma unroll
        for (int ai = 0; ai < 2; ++ai)
#pragma unroll
            for (int m = 0; m < 4; ++m)
#pragma unroll
                for (int bj = 0; bj < 2; ++bj) store_bf16x8_wt(O + (size_t)(ai * 128 + m * 16) * d.ldo + bj * 128, acc[ai][bj][m][0] * rs[ai][m], acc[ai][bj][m][1] * rs[ai][m]);
    } break;
    default: break;
    }
    }
}
#undef EPI_FP8_CASES

typedef int i32x8 __attribute__((ext_vector_type(8)));
typedef int i32x4 __attribute__((ext_vector_type(4)));
template <bool FP8>
__device__ __forceinline__ void gemm_phase(LAS unsigned char* lds, const Desc& prob) {
    int tid = threadIdx.x; asm volatile("" : "+v"(tid));
    const int wid = __builtin_amdgcn_readfirstlane(tid >> 6), lane = tid & 63, wr = wid >> 2, wc = wid & 3, fr = lane & 15, fq = lane >> 4;
    const int esz = FP8 ? 1 : 2;
    const int nt = prob.K * esz / 128;
    int sc_w = prob.sc_w, sc_a = prob.sc_a; asm volatile("" : "+v"(sc_w), "+v"(sc_a));
    unsigned voffA[2], voffB[2];
#pragma unroll
    for (int i = 0; i < 2; ++i) { int R, C; stage_rc(tid * 16 + i * 8192, R, C); const int Rb = (R & ~31) + perm32(R & 31);
        voffA[i] = (unsigned)(R * prob.lda * esz + C * 2); voffB[i] = (unsigned)(Rb * prob.ldb * esz + C * 2); }
    const size_t kstep = 128;
    const size_t hstepA = (size_t)HALF * prob.lda * esz, hstepB = (size_t)HALF * prob.ldb * esz;
    const unsigned ldsw = (unsigned)wid * 1024u;
    const int aoff = lds_byte(wr * 64 + fr, fq * 8), boff = lds_byte(wc * 32 + fr, fq * 8);
    LAS unsigned* const rtab = (LAS unsigned*)(lds + STAGE_BYTES + 1024);
    unsigned goffC[2][2] = {{0u, 0u}, {0u, 0u}}, goffN[2][2] = {{0u, 0u}, {0u, 0u}}; int gR0 = 0; unsigned gC2 = 0u;
    const bool GAT = FP8 && prob.gidx != nullptr;
    if (GAT) {
        int grow[4], gval[4];
#pragma unroll
        for (int q = 0; q < 4; ++q) { const int uu = __builtin_amdgcn_readfirstlane((tid >> 8) + 2 * q), r = tid & 255; Tile tt;
            grow[q] = get_tile(prob, uu, tt) ? tt.pm * 256 + r : -1; gval[q] = prob.gidx[grow[q] < 0 ? 0 : grow[q]]; }
        asm volatile("" : "+v"(gval[0]), "+v"(gval[1]), "+v"(gval[2]), "+v"(gval[3]));
#pragma unroll
        for (int q = 0; q < 4; ++q) { const int uu = __builtin_amdgcn_readfirstlane((tid >> 8) + 2 * q), r = tid & 255;
            if (grow[q] >= 0) rtab[uu * 256 + r] = (unsigned)(((grow[q] >> 9) & 3) * 4096 + gval[q]) * (unsigned)prob.lda; }
        __syncthreads();
        { int R, C; stage_rc(tid * 16, R, C); gR0 = R; gC2 = (unsigned)(C * 2); }
    }
#define G8_GOFF(dst, uord) do { _Pragma("unroll") for (int _h = 0; _h < 2; ++_h) _Pragma("unroll") for (int _i = 0; _i < 2; ++_i) dst[_h][_i] = rtab[((uord) & 7) * 256 + _h * 128 + gR0 + 64 * _i] + gC2; } while (0)
#define G8_STGA(bufoff, h, nx, ptr, kb) do { if (GAT) { _Pragma("unroll") for (int _i = 0; _i < 2; ++_i) { const unsigned _o = ((nx) ? goffN[h][_i] : goffC[h][_i]) + (unsigned)(kb); \
            __builtin_amdgcn_global_load_lds((const unsigned*)((const char*)prob.A + _o), (LAS unsigned*)(lds + (bufoff) + ldsw + _i * 8192), 16, 0, 0); } } \
        else { G8_STAGE(bufoff, (ptr) + ((h) ? hstepA : 0), voffA); } } while (0)
#define G8_SA(b, h) (((b) * 2 + (h)) * HTB)
#define G8_SB(b, h) ((4 + (b) * 2 + (h)) * HTB)
#define G8_STAGE(bufoff, gbase, voff) do { _Pragma("unroll") for (int _i = 0; _i < 2; ++_i) \
        __builtin_amdgcn_global_load_lds((const unsigned*)((const char*)(gbase) + (voff)[_i]), (LAS unsigned*)(lds + (bufoff) + ldsw + _i * 8192), 16, 0, 0); } while (0)
#define G8_LDA(dst, b, h) do { _Pragma("unroll") for (int m = 0; m < 4; ++m) _Pragma("unroll") for (int k = 0; k < 2; ++k) dst[m][k] = *(const LAS i32x4*)(lds + G8_SA(b, h) + aoff + m * 2048 + k * 1024); } while (0)
#define G8_LDB(dst, b, h) do { _Pragma("unroll") for (int n = 0; n < 2; ++n) _Pragma("unroll") for (int k = 0; k < 2; ++k) dst[n][k] = *(const LAS i32x4*)(lds + G8_SB(b, h) + boff + n * 2048 + k * 1024); } while (0)
#define G8_CAT(v) __builtin_shufflevector(v[0], v[1], 0, 1, 2, 3, 4, 5, 6, 7)
#define G8_MMA(ai, bj, At, Bt) do { __builtin_amdgcn_s_setprio(1); \
        if constexpr (FP8) { _Pragma("unroll") for (int m = 0; m < 4; ++m) _Pragma("unroll") for (int n = 0; n < 2; ++n) { const i32x8 _w = G8_CAT(Bt[n]), _x = G8_CAT(At[m]); \
            asm volatile("s_nop 1\n\tv_mfma_scale_f32_16x16x128_f8f6f4 %0, %1, %2, %0, %3, %4 op_sel_hi:[0,0,0]" : "+v"(acc[ai][bj][m][n]) : "v"(_w), "v"(_x), "v"(sc_w), "v"(sc_a)); } } \
        else { _Pragma("unroll") for (int m = 0; m < 4; ++m) _Pragma("unroll") for (int n = 0; n < 2; ++n) _Pragma("unroll") for (int k = 0; k < 2; ++k) \
            acc[ai][bj][m][n] = __builtin_amdgcn_mfma_f32_16x16x32_bf16((bf16x8)Bt[n][k], (bf16x8)At[m][k], acc[ai][bj][m][n], 0, 0, 0); } \
        __builtin_amdgcn_s_setprio(0); } while (0)
#define G8_WAIT_V(n) asm volatile("s_waitcnt vmcnt(" #n ")" ::: "memory")
#define G8_WAIT_L(n) asm volatile("s_waitcnt lgkmcnt(" #n ")" ::: "memory")
#define G8_BAR __builtin_amdgcn_s_barrier()
#define G8_SCHED __builtin_amdgcn_sched_barrier(0)
    Tile cur, nxt; int ui = 0;
    if (!get_tile(prob, 0, cur)) return;
    Acc acc;
#pragma unroll
    for (int a = 0; a < 2; ++a)
#pragma unroll
        for (int b = 0; b < 2; ++b)
#pragma unroll
            for (int m = 0; m < 4; ++m)
#pragma unroll
                for (int n = 0; n < 2; ++n) acc[a][b][m][n] = (f32x4){0.f, 0.f, 0.f, 0.f};
    i32x4 At[4][2], B0[2][2], B1[2][2];
    const char* cA = cur.a; const char* cB = cur.b;
    if (GAT) { G8_GOFF(goffC, 0); }
    G8_STAGE(G8_SB(0, 0), cB, voffB); G8_STAGE(G8_SB(0, 1), cB + hstepB, voffB); G8_STGA(G8_SA(0, 0), 0, false, cA, 0); G8_STGA(G8_SA(0, 1), 1, false, cA, 0);
    if (wr == 1) G8_BAR;
    G8_WAIT_V(2); G8_BAR;
    G8_STAGE(G8_SB(1, 0), cB + kstep, voffB); G8_STGA(G8_SA(1, 0), 0, false, cA + kstep, 128); G8_STAGE(G8_SB(1, 1), cB + hstepB + kstep, voffB);
    G8_WAIT_V(6); G8_BAR;
    for (;;) {
        const bool has_next = get_tile(prob, ui + 1, nxt);
        const char* nA = has_next ? nxt.a : cA; const char* nB = has_next ? nxt.b : cB;
        if (GAT) { G8_GOFF(goffN, has_next ? ui + 1 : ui); }
        for (int t = 0; t < nt; t += 2) {
            const bool last = (t == nt - 2);
            const char* a1 = cA + (size_t)(t + 1) * kstep;
            const char* a2 = last ? nA : cA + (size_t)(t + 2) * kstep; const char* b2 = last ? nB : cB + (size_t)(t + 2) * kstep;
            const char* a3 = a2 + kstep; const char* b3 = b2 + kstep;
            G8_LDB(B0, 0, 0); G8_LDB(B1, 0, 1); G8_SCHED; G8_LDA(At, 0, 0); G8_STGA(G8_SA(1, 1), 1, false, a1, (t + 1) * 128);
            G8_WAIT_V(8); G8_WAIT_L(0); G8_BAR; G8_MMA(0, 0, At, B0); G8_MMA(0, 1, At, B1); G8_BAR; G8_SCHED;
            G8_LDA(At, 0, 1); G8_STAGE(G8_SB(0, 0), b2, voffB); G8_STAGE(G8_SB(0, 1), b2 + hstepB, voffB); G8_STGA(G8_SA(0, 0), 0, last, a2, last ? 0 : (t + 2) * 128);
            G8_WAIT_V(8); G8_WAIT_L(0); G8_BAR; G8_MMA(1, 0, At, B0); G8_MMA(1, 1, At, B1); G8_BAR; G8_SCHED;
            G8_LDB(B0, 1, 0); G8_LDB(B1, 1, 1); G8_SCHED; G8_LDA(At, 1, 0); G8_STGA(G8_SA(0, 1), 1, last, a2, last ? 0 : (t + 2) * 128);
            G8_WAIT_V(8); G8_WAIT_L(0); G8_BAR; G8_MMA(0, 0, At, B0); G8_MMA(0, 1, At, B1); G8_BAR; G8_SCHED;
            G8_LDA(At, 1, 1); G8_STAGE(G8_SB(1, 0), b3, voffB); G8_STAGE(G8_SB(1, 1), b3 + hstepB, voffB); G8_STGA(G8_SA(1, 0), 0, last, a3, last ? 128 : (t + 3) * 128);
            G8_WAIT_V(8); G8_WAIT_L(0); G8_BAR; G8_MMA(1, 0, At, B0); G8_MMA(1, 1, At, B1); G8_BAR; G8_SCHED;
        }
        if (wr == 0) G8_BAR;
        if (FP8) asm volatile("s_nop 15\n\ts_nop 15" ::: "memory");
        epilogue<FP8>(prob, acc, cur);
        if (!has_next) break;
#pragma unroll
        for (int a = 0; a < 2; ++a)
#pragma unroll
            for (int b = 0; b < 2; ++b)
#pragma unroll
                for (int m = 0; m < 4; ++m)
#pragma unroll
                    for (int n = 0; n < 2; ++n) acc[a][b][m][n] = (f32x4){0.f, 0.f, 0.f, 0.f};
        cur = nxt; cA = nA; cB = nB; ++ui;
        if (GAT) {
#pragma unroll
            for (int _h = 0; _h < 2; ++_h)
#pragma unroll
                for (int _i = 0; _i < 2; ++_i) goffC[_h][_i] = goffN[_h][_i]; }
        if (wr == 1) G8_BAR;
    }
    G8_WAIT_V(0);
    G8_BAR;
#undef G8_SA
#undef G8_SB
#undef G8_STAGE
#undef G8_STGA
#undef G8_GOFF
#undef G8_LDA
#undef G8_LDB
#undef G8_CAT
#undef G8_MMA
#undef G8_WAIT_V
#undef G8_WAIT_L
#undef G8_BAR
#undef G8_SCHED
}
}

struct Args { const float* in[25]; float* out; unsigned char* ws; int ph_lo, ph_hi; };
struct Ctx {
    LAS unsigned char* lds;
    int tid, lane, wave, G, gw, NGW, z;
};
__device__ __forceinline__ int opaque_zero() { int z; asm volatile("s_mov_b32 %0, 0" : "=s"(z)); return z; }
__device__ __forceinline__ Ctx make_ctx(LAS unsigned char* lds) {
    Ctx F; F.lds = lds; F.z = opaque_zero();
    int tz = threadIdx.x; asm volatile("" : "+v"(tz));
    F.tid = tz; F.lane = tz & 63; F.wave = __builtin_amdgcn_readfirstlane(tz >> 6);
    F.G = gridDim.x; { const int bx = blockIdx.x; const int vcu = (F.G % 8 == 0) ? (bx % 8) * (F.G / 8) + bx / 8 : bx; F.gw = vcu * NWAVES + F.wave; }
    F.NGW = F.G * NWAVES;
    return F;
}
#define WSP(T_, off) ((T_*)(args.ws + ((size_t)(off) + (size_t)F.z)))
#define INP(k) (args.in[(k) + F.z])
#define CTXA LAS unsigned char* lds_, const Args& args
#define CTX_LOCAL() const Ctx F = make_ctx(lds_)

__device__ __forceinline__ void tr_item(const float* W, int K, int N, bf16* WT, int drow0, LAS float* scr, int k0, int n0, int lane, const float* ks) {
#pragma unroll 8
    for (int i = 0; i < 32; ++i) { const int kk = 2 * i + (lane >> 5); scr[kk * 33 + (lane & 31)] = __builtin_nontemporal_load(W + (size_t)(k0 + kk) * N + n0 + (lane & 31)) * (ks ? ks[k0 + kk] : 1.f); }
    LDS_WAIT(); asm volatile("" ::: "memory");
    const int c = lane & 7;
#pragma unroll
    for (int j = 0; j < 4; ++j) { const int n = (lane >> 3) + 8 * j; const LAS float* s = scr + (8 * c) * 33 + n;
        u32x4 o; o.x = cvt_pk_bf16(s[0 * 33], s[1 * 33]); o.y = cvt_pk_bf16(s[2 * 33], s[3 * 33]); o.z = cvt_pk_bf16(s[4 * 33], s[5 * 33]); o.w = cvt_pk_bf16(s[6 * 33], s[7 * 33]);
        *(u32x4*)(WT + (size_t)(drow0 + n) * K + k0 + 8 * c) = o; }
    LDS_WAIT(); asm volatile("" ::: "memory");
}

__device__ __forceinline__ void tr_item8(const float* W, int K, int N, unsigned char* WT, int drow0, LAS float* scr, int k0, int n0, int lane, float sc) {
#pragma unroll 8
    for (int i = 0; i < 32; ++i) { const int kk = 2 * i + (lane >> 5); scr[kk * 33 + (lane & 31)] = __builtin_nontemporal_load(W + (size_t)(k0 + kk) * N + n0 + (lane & 31)); }
    LDS_WAIT(); asm volatile("" ::: "memory");
    const int c = lane & 7;
#pragma unroll
    for (int j = 0; j < 4; ++j) { const int n = (lane >> 3) + 8 * j; const LAS float* s = scr + (8 * c) * 33 + n;
        u32x2 o; o.x = pk4_fp8(clamp448(sc * s[0 * 33]), clamp448(sc * s[1 * 33]), clamp448(sc * s[2 * 33]), clamp448(sc * s[3 * 33]));
        o.y = pk4_fp8(clamp448(sc * s[4 * 33]), clamp448(sc * s[5 * 33]), clamp448(sc * s[6 * 33]), clamp448(sc * s[7 * 33]));
        __builtin_nontemporal_store(o, (u32x2*)(WT + (size_t)(drow0 + n) * K + k0 + 8 * c)); }
    LDS_WAIT(); asm volatile("" ::: "memory");
}

__device__ __forceinline__ void p0_prologue(CTXA) {
    CTX_LOCAL();
    LAS float* scr = (LAS float*)(F.lds + F.wave * 16384);
    constexpr int I_EXP = 1024;
    constexpr int N_GU = DEPTH * NE * 2 * I_EXP;
    constexpr int N_DN = DEPTH * NE * I_EXP;
    constexpr int N_WIN = 2 * 1024;
    constexpr int N_SQ = 10 * 512;
    constexpr int N_GT = 32 * 32;
    constexpr int N_PP = 4 * 128;
    constexpr int NITEMS = N_GU + N_DN + N_WIN + N_SQ + N_GT + N_PP;
    for (int it = F.gw; it < NITEMS; it += F.NGW) {
        int r = it; const float* src; bf16* dst; int K, N, k0, n0, drow0; const float* ks = nullptr;
        if (r < N_GU) { const int m = r >> 10, q = r & 1023, which = m & 1, le = m >> 1;
            const int k0e = (q >> 6) * 64, n0e = (q & 63) * 32;
            tr_item8(INP(which ? 21 : 20) + (size_t)le * 1024 * 2048, 1024, 2048, WSP(unsigned char, WS_W1T) + (size_t)le * 4096 * 1024, (n0e >> 7) * 256 + which * 128 + (n0e & 127), scr, k0e, n0e, F.lane, which ? (-512.f * 4.f / L2E) : (-512.f * L2E)); continue; }
        else if ((r -= N_GU) < N_DN) { const int le = r >> 10, q = r & 1023;
            const int k0e = (q >> 5) * 64, n0e = (q & 31) * 32;
            tr_item8(INP(22) + (size_t)le * 2048 * 1024, 2048, 1024, WSP(unsigned char, WS_W2T) + (size_t)le * 1024 * 2048, n0e, scr, k0e, n0e, F.lane, 512.f); continue; }
        else if ((r -= N_DN) < N_WIN) { const int j = r >> 10, q = r & 1023;
            src = INP(6) + (size_t)j * 1024 * 2048; dst = WSP(bf16, WS_WINT) + (size_t)j * 2048 * 1024; K = 1024; N = 2048; ks = INP(2) + (size_t)(2 * j) * D;
            k0 = (q >> 6) * 64; n0 = (q & 63) * 32; drow0 = n0; }
        else if ((r -= N_WIN) < N_SQ) { const int mi = r >> 9, q = r & 511; K = 1024; N = 1024; k0 = (q >> 5) * 64; n0 = (q & 31) * 32; drow0 = n0;
            if (mi < 2) { src = INP(15) + (size_t)mi * 1048576; dst = WSP(bf16, WS_WOUTT) + (size_t)mi * 1048576; }
            else if (mi < 4) { src = INP(17) + (size_t)(mi - 2) * 1048576; dst = WSP(bf16, WS_FTINT) + (size_t)(mi - 2) * 1048576; ks = INP(2) + (size_t)(2 * (mi - 2) + 1) * D; }
            else if (mi < 6) { src = INP(18) + (size_t)(mi - 4) * 1048576; dst = WSP(bf16, WS_FTOUTT) + (size_t)(mi - 4) * 1048576; }
            else { tr_item8(INP(24) + (size_t)(mi - 6) * 1048576, 1024, 1024, WSP(unsigned char, WS_PLEGT) + (size_t)(mi - 6) * 1048576, n0, scr, k0, n0, F.lane, 512.f); continue; } }
        else if ((r -= N_SQ) < N_GT) { const int mi = r >> 5, q = r & 31;
            const int head = mi & 3, d = (mi >> 2) & 1, j = (mi >> 3) & 1, which = mi >> 4;
            src = INP(which ? 12 : 10) + (size_t)((j * 2 + d) * 4 + head) * 65536; dst = WSP(bf16, WS_GATET) + (size_t)(j * 4 + head) * 1024 * 256; K = 256; N = 256;
            k0 = (q >> 3) * 64; n0 = (q & 7) * 32; drow0 = ((d * 2 + (n0 >> 7)) * 2 + which) * 128 + (n0 & 127); }
        else { r -= N_GT; const int li = r >> 7, q = r & 127;
            src = INP(23) + (size_t)li * 256 * 1024; dst = WSP(bf16, WS_PLEPT) + (size_t)li * 1024 * 256; K = 256; N = 1024;
            k0 = (q >> 5) * 64; n0 = (q & 31) * 32; drow0 = n0; }
        tr_item(src, K, N, dst, drow0, scr, k0, n0, F.lane, ks);
    }
    { const float* X = INP(0); bf16* HB = WSP(bf16, WS_HB); float* SSQ = WSP(float, WS_SSQ);
      for (int row0 = F.gw; row0 < T; row0 += 2 * F.NGW) { f32x4 xv[2][4];
#pragma unroll
          for (int rr = 0; rr < 2; ++rr)
#pragma unroll
              for (int j = 0; j < 4; ++j) xv[rr][j] = __builtin_nontemporal_load((const f32x4*)(X + (size_t)(row0 + rr * F.NGW) * D + 4 * F.lane + 256 * j));
          asm volatile("" : "+v"(xv[0][0]), "+v"(xv[0][1]), "+v"(xv[0][2]), "+v"(xv[0][3]), "+v"(xv[1][0]), "+v"(xv[1][1]), "+v"(xv[1][2]), "+v"(xv[1][3]));
#pragma unroll
          for (int rr = 0; rr < 2; ++rr) { const int row = row0 + rr * F.NGW; float ss = 0.f;
#pragma unroll
              for (int j = 0; j < 4; ++j) { const size_t o = (size_t)row * D + 4 * F.lane + 256 * j; const f32x4 v = xv[rr][j];
                  u32x2 w; w.x = cvt_pk_bf16(v[0], v[1]); w.y = cvt_pk_bf16(v[2], v[3]); *(u32x2*)(HB + o) = w; ss += (v[0] * v[0] + v[1] * v[1]) + (v[2] * v[2] + v[3] * v[3]); }
              ss = wave_sum(ss); if (F.lane < 16) SSQ[(size_t)row * 16 + F.lane] = F.lane ? 0.f : ss; } } }
    const size_t gt = (size_t)blockIdx.x * NTHREADS + F.tid, NGT = (size_t)F.G * NTHREADS;
    { const float* p = INP(1); bf16* o = WSP(bf16, WS_PBF);
      for (size_t i0 = gt; i0 < (size_t)DEPTH * T * PLE / 8; i0 += 4 * NGT) { f32x4 pa[4], pb[4];
#pragma unroll
          for (int q = 0; q < 4; ++q) { const size_t i = i0 + q * NGT; const bool ok = i < (size_t)DEPTH * T * PLE / 8; const size_t ii = ok ? i : i0;
              pa[q] = __builtin_nontemporal_load((const f32x4*)(p + ii * 8)); pb[q] = __builtin_nontemporal_load((const f32x4*)(p + ii * 8 + 4)); }
          asm volatile("" : "+v"(pa[0]), "+v"(pa[1]), "+v"(pa[2]), "+v"(pa[3]), "+v"(pb[0]), "+v"(pb[1]), "+v"(pb[2]), "+v"(pb[3]));
#pragma unroll
          for (int q = 0; q < 4; ++q) { const size_t i = i0 + q * NGT; if (i < (size_t)DEPTH * T * PLE / 8) { const f32x4 a = pa[q], b = pb[q];
              u32x4 w; w.x = cvt_pk_bf16(a[0], a[1]); w.y = cvt_pk_bf16(a[2], a[3]); w.z = cvt_pk_bf16(b[0], b[1]); w.w = cvt_pk_bf16(b[2], b[3]); *(u32x4*)(o + i * 8) = w; } } } }
    { bf16* o = WSP(bf16, WS_DFTC);
      for (size_t i = gt; i < 512 * 256 / 8; i += NGT) { const int n = (int)(i >> 5), c0 = (int)(i & 31) * 8, l = n & 255; float v[8];
#pragma unroll
          for (int j = 0; j < 8; ++j) { const int mm = (l * (c0 + j)) & 255; const float x = (float)mm * (1.f / 256.f); v[j] = (n < 256) ? __builtin_amdgcn_cosf(x) : __builtin_amdgcn_sinf(x); }
          u32x4 w; w.x = cvt_pk_bf16(v[0], v[1]); w.y = cvt_pk_bf16(v[2], v[3]); w.z = cvt_pk_bf16(v[4], v[5]); w.w = cvt_pk_bf16(v[6], v[7]); *(u32x4*)(o + i * 8) = w; } }
    { bf16* o = WSP(bf16, WS_DFTS);
      for (size_t i = gt; i < (size_t)4096 * (KH / 8); i += NGT) { const int r = (int)(i / (KH / 8)), c0 = (int)(i % (KH / 8)) * 8, k = r & 2047; float v[8];
#pragma unroll
          for (int j = 0; j < 8; ++j) { const int c = c0 + j; const int mm = (k * (c & 2047)) & 4095; const float x = (float)mm * (1.f / 4096.f);
              v[j] = (c < 2048) ? ((r < 2048) ? __builtin_amdgcn_cosf(x) : __builtin_amdgcn_sinf(x)) * (1.f / 1024.f) : (c == 2048 && r < 2048) ? ((k & 1) ? -1.f / 1024.f : 1.f / 1024.f) : 0.f; }
          u32x4 w; w.x = cvt_pk_bf16(v[0], v[1]); w.y = cvt_pk_bf16(v[2], v[3]); w.z = cvt_pk_bf16(v[4], v[5]); w.w = cvt_pk_bf16(v[6], v[7]); *(u32x4*)(o + i * 8) = w; } }
}

__device__ __forceinline__ void final_pass(CTXA) {
    CTX_LOCAL();
    const bf16* H = WSP(bf16, WS_HB); const float* g = INP(5);
    f32x4 gv[4];
#pragma unroll
    for (int j = 0; j < 4; ++j) gv[j] = *(const f32x4*)(g + 4 * F.lane + 256 * j);
    const int vcu = F.gw / NWAVES, ntrip = ((T / 64 - vcu + F.G - 1) / F.G) * 4;
    for (int tp = 0; tp < ntrip; ++tp) { const int row0 = (vcu + (tp >> 2) * F.G) * 64 + 8 * F.wave + 2 * (tp & 3);
        f32x4 v[2][4];
#pragma unroll
        for (int rr = 0; rr < 2; ++rr)
#pragma unroll
            for (int j = 0; j < 4; ++j) { const u32x2 w = *(const u32x2*)(H + (size_t)(row0 + rr) * D + 4 * F.lane + 256 * j); v[rr][j] = (f32x4){bf_lo(w.x), bf_hi(w.x), bf_lo(w.y), bf_hi(w.y)}; }
#pragma unroll
        for (int rr = 0; rr < 2; ++rr) { float ss = 0.f;
#pragma unroll
            for (int j = 0; j < 4; ++j) ss += (v[rr][j][0] * v[rr][j][0] + v[rr][j][1] * v[rr][j][1]) + (v[rr][j][2] * v[rr][j][2] + v[rr][j][3] * v[rr][j][3]);
            const float rs = rsqrtf(wave_sum(ss) * (1.f / D) + EPS);
#pragma unroll
            for (int j = 0; j < 4; ++j) *(f32x4*)(args.out + (size_t)(row0 + rr) * D + 4 * F.lane + 256 * j) = v[rr][j] * rs * gv[j]; }
    }
}
__device__ __forceinline__ void router_pass(CTXA, int layer) {
    CTX_LOCAL();
    unsigned char* XN8 = WSP(unsigned char, WS_XN); const bf16* H = WSP(bf16, WS_HB); float* AFF = WSP(float, WS_AFF);
    const float* g = INP(3) + layer * D; const float* wr = INP(19) + (size_t)layer * D * NE;
    LAS unsigned char* wt = F.lds;
    LAS float* gl = (LAS float*)(F.lds + 98304);
    LAS float* xb = (LAS float*)(F.lds + 98304 + 4096);
    const int fr = F.lane & 15, fq = F.lane >> 4, half = F.wave & 1, pr = F.wave >> 1;
    const int NT16 = T / 16;
    int base = (F.gw / NWAVES) * 4;
    u32x4 hw[8][2];
#define RT_LOAD(tb) do { const bf16* hp_ = H + (size_t)(((tb) + pr) * 16 + fr) * D + 512 * half + 16 * fq; \
        _Pragma("unroll") for (int j = 0; j < 8; ++j) { hw[j][0] = *(const u32x4*)(hp_ + 64 * j); hw[j][1] = *(const u32x4*)(hp_ + 64 * j + 8); } } while (0)
    { float tmp[32];
#pragma unroll
      for (int q4 = 0; q4 < 4; ++q4) { const int it = F.tid + q4 * NTHREADS, e = it & 15, ch = it >> 4, s = ch >> 2, k0 = 64 * (s >> 1) + 16 * (ch & 3) + 8 * (s & 1);
#pragma unroll
          for (int q = 0; q < 8; ++q) tmp[q4 * 8 + q] = wr[(k0 + q) * NE + e]; }
#pragma unroll
      for (int q4 = 0; q4 < 4; ++q4) { const int it = F.tid + q4 * NTHREADS, ch = it >> 4, s = ch >> 2, k0 = 64 * (s >> 1) + 16 * (ch & 3) + 8 * (s & 1);
          const f32x4 g0 = *(const f32x4*)(g + k0), g1 = *(const f32x4*)(g + k0 + 4);
          float w[8], r1[8], r2[8]; unsigned hi[4], lo[4], l2[4];
#pragma unroll
          for (int q = 0; q < 8; ++q) w[q] = tmp[q4 * 8 + q] * (q < 4 ? g0[q] : g1[q - 4]);
#pragma unroll
          for (int q = 0; q < 4; ++q) { hi[q] = cvt_pk_bf16(w[2 * q], w[2 * q + 1]); r1[2 * q] = w[2 * q] - bf_lo(hi[q]); r1[2 * q + 1] = w[2 * q + 1] - bf_hi(hi[q]); }
#pragma unroll
          for (int q = 0; q < 4; ++q) { lo[q] = cvt_pk_bf16(r1[2 * q], r1[2 * q + 1]); r2[2 * q] = r1[2 * q] - bf_lo(lo[q]); r2[2 * q + 1] = r1[2 * q + 1] - bf_hi(lo[q]); }
#pragma unroll
          for (int q = 0; q < 4; ++q) l2[q] = cvt_pk_bf16(r2[2 * q], r2[2 * q + 1]);
          *(LAS u32x4*)(wt + it * 16) = (u32x4){hi[0], hi[1], hi[2], hi[3]}; *(LAS u32x4*)(wt + 32768 + it * 16) = (u32x4){lo[0], lo[1], lo[2], lo[3]}; *(LAS u32x4*)(wt + 65536 + it * 16) = (u32x4){l2[0], l2[1], l2[2], l2[3]}; }
      gl[F.tid] = g[F.tid]; gl[F.tid + NTHREADS] = g[F.tid + NTHREADS]; }
    __syncthreads();
    while (base < NT16) {
        RT_LOAD(base);
        const int row = (base + pr) * 16 + fr;
        f32x4 a0 = {0.f, 0.f, 0.f, 0.f}, a1 = a0, a2 = a0; float ss = 0.f;
#pragma unroll
        for (int j = 0; j < 8; ++j)
#pragma unroll
            for (int t = 0; t < 2; ++t) { const int s = (8 * half + j) * 2 + t; LAS unsigned char* wp = wt + s * 1024 + F.lane * 16;
                const u32x4 w0 = *(const LAS u32x4*)wp, w1 = *(const LAS u32x4*)(wp + 32768), w2 = *(const LAS u32x4*)(wp + 65536); const u32x4 h = hw[j][t];
                a0 = __builtin_amdgcn_mfma_f32_16x16x32_bf16((bf16x8)w0, (bf16x8)h, a0, 0, 0, 0);
                a1 = __builtin_amdgcn_mfma_f32_16x16x32_bf16((bf16x8)w1, (bf16x8)h, a1, 0, 0, 0);
                a2 = __builtin_amdgcn_mfma_f32_16x16x32_bf16((bf16x8)w2, (bf16x8)h, a2, 0, 0, 0);
                ss += ((bf_lo(h.x) * bf_lo(h.x) + bf_hi(h.x) * bf_hi(h.x)) + (bf_lo(h.y) * bf_lo(h.y) + bf_hi(h.y) * bf_hi(h.y))) + ((bf_lo(h.z) * bf_lo(h.z) + bf_hi(h.z) * bf_hi(h.z)) + (bf_lo(h.w) * bf_lo(h.w) + bf_hi(h.w) * bf_hi(h.w))); }
        ss += __shfl_xor(ss, 16); ss += __shfl_xor(ss, 32);
        f32x4 acc = (a2 + a1) + a0;
        LAS float* xp = xb + pr * 384;
        if (half == 1) { xp[F.lane] = acc[0]; xp[64 + F.lane] = acc[1]; xp[128 + F.lane] = acc[2]; xp[192 + F.lane] = acc[3]; xp[256 + F.lane] = ss; } else xp[320 + F.lane] = ss;
        __syncthreads();
        const float rs = rsqrtf((ss + (half == 1 ? xp[320 + F.lane] : xp[256 + F.lane])) * (1.f / D) + EPS), rs8 = __builtin_ldexpf(rs, 3);
#pragma unroll
        for (int j = 0; j < 8; ++j) { const int k = 512 * half + 64 * j + 16 * fq; u32x4 o;
#pragma unroll
            for (int t = 0; t < 2; ++t) { const f32x4 g0 = *(const LAS f32x4*)(gl + k + 8 * t), g1 = *(const LAS f32x4*)(gl + k + 8 * t + 4); const u32x4 h = hw[j][t];
                const unsigned p0 = pk4_fp8(clamp448(bf_lo(h.x) * g0[0] * rs8), clamp448(bf_hi(h.x) * g0[1] * rs8), clamp448(bf_lo(h.y) * g0[2] * rs8), clamp448(bf_hi(h.y) * g0[3] * rs8));
                const unsigned p1 = pk4_fp8(clamp448(bf_lo(h.z) * g1[0] * rs8), clamp448(bf_hi(h.z) * g1[1] * rs8), clamp448(bf_lo(h.w) * g1[2] * rs8), clamp448(bf_hi(h.w) * g1[3] * rs8));
                if (t == 0) { o.x = p0; o.y = p1; } else { o.z = p0; o.w = p1; } }
            g8::stg16_wt(XN8 + (size_t)row * D + k, o); }
        if (half == 0) {
            f32x4 lg; lg[0] = (acc[0] + xp[F.lane]) * rs; lg[1] = (acc[1] + xp[64 + F.lane]) * rs; lg[2] = (acc[2] + xp[128 + F.lane]) * rs; lg[3] = (acc[3] + xp[192 + F.lane]) * rs;
            float mx = fmaxf(fmaxf(lg[0], lg[1]), fmaxf(lg[2], lg[3])); mx = fmaxf(mx, __shfl_xor(mx, 16)); mx = fmaxf(mx, __shfl_xor(mx, 32));
            f32x4 ex; float sum = 0.f;
#pragma unroll
            for (int j = 0; j < 4; ++j) { ex[j] = __expf(lg[j] - mx); sum += ex[j]; }
            sum += __shfl_xor(sum, 16); sum += __shfl_xor(sum, 32);
            const int b = row >> 12, s = row & 4095;
#pragma unroll
            for (int j = 0; j < 4; ++j) AFF[((size_t)(b * NE + 4 * fq + j)) * S + s] = ex[j] / sum;
        }
        base += F.G * 4;
        __syncthreads();
    }
#undef RT_LOAD
}

__device__ __forceinline__ void conv_pass(CTXA, int j) {
    CTX_LOCAL();
    const bf16* U = WSP(bf16, WS_BUFB); bf16* O = WSP(bf16, WS_BUFC);
    const float* cw = INP(8) + (size_t)j * 4 * D; const float* cb = INP(9) + (size_t)j * D;
    const int vcu = F.gw / NWAVES, rsub = F.tid >> 7;
    const int c0 = (F.tid & 127) * 8;
    float tw[4][8], tb[8];
    { const f32x4 b0 = *(const f32x4*)(cb + c0), b1 = *(const f32x4*)(cb + c0 + 4); tb[0] = b0[0]; tb[1] = b0[1]; tb[2] = b0[2]; tb[3] = b0[3]; tb[4] = b1[0]; tb[5] = b1[1]; tb[6] = b1[2]; tb[7] = b1[3]; }
#pragma unroll
    for (int k = 0; k < 4; ++k) { const f32x4 w0 = *(const f32x4*)(cw + k * D + c0), w1 = *(const f32x4*)(cw + k * D + c0 + 4);
        tw[k][0] = w0[0]; tw[k][1] = w0[1]; tw[k][2] = w0[2]; tw[k][3] = w0[3]; tw[k][4] = w1[0]; tw[k][5] = w1[1]; tw[k][6] = w1[2]; tw[k][7] = w1[3]; }
    for (int tp = 0; tp < ((T / 64 - vcu + F.G - 1) / F.G) * 4; ++tp) {
        const int rbase = (vcu + (tp >> 2) * F.G) * 64 + 16 * (tp & 3) + rsub;
        u32x4 uw[4][4];
#pragma unroll
        for (int q = 0; q < 4; ++q) { const int row = rbase + 4 * q, s = row & 4095;
#pragma unroll
            for (int k = 0; k < 4; ++k) { const int ss = s + k - 2; uw[q][k] = (ss >= 0 && ss < S) ? *(const u32x4*)(U + (size_t)(row + k - 2) * D + c0) : (u32x4){0u, 0u, 0u, 0u}; } }
#pragma unroll
        for (int q = 0; q < 4; ++q) { const int row = rbase + 4 * q;
            float a[8];
#pragma unroll
            for (int e = 0; e < 8; ++e) a[e] = tb[e];
#pragma unroll
            for (int k = 0; k < 4; ++k) { const u32x4 x = uw[q][k];
                a[0] += bf_lo(x.x) * tw[k][0]; a[1] += bf_hi(x.x) * tw[k][1]; a[2] += bf_lo(x.y) * tw[k][2]; a[3] += bf_hi(x.y) * tw[k][3];
                a[4] += bf_lo(x.z) * tw[k][4]; a[5] += bf_hi(x.z) * tw[k][5]; a[6] += bf_lo(x.w) * tw[k][6]; a[7] += bf_hi(x.w) * tw[k][7]; }
            u32x4 w; w.x = cvt_pk_bf16(a[0], a[1]); w.y = cvt_pk_bf16(a[2], a[3]); w.z = cvt_pk_bf16(a[4], a[5]); w.w = cvt_pk_bf16(a[6], a[7]); *(u32x4*)(O + (size_t)row * D + c0) = w; }
    }
}

__device__ __forceinline__ void ft_fold_pass(CTXA) {
    CTX_LOCAL();
    const bf16* U = WSP(bf16, WS_BUFA); bf16* UF = WSP(bf16, WS_BUFB); bf16* PQ = WSP(bf16, WS_LA);
    const size_t gt = (size_t)blockIdx.x * NTHREADS + F.tid, NGT = (size_t)F.G * NTHREADS;
    for (size_t i0 = gt; i0 < (size_t)NB * 2048 * (D / 8); i0 += 4 * NGT) {
        u32x4 xs4[4], ys4[4];
#pragma unroll
        for (int q = 0; q < 4; ++q) { const size_t i = i0 + q * NGT; const int c0 = (int)(i & 127) * 8, s = (int)(i >> 7) & 2047, b = (int)(i >> 18);
            xs4[q] = *(const u32x4*)(U + ((size_t)b * S + s) * D + c0); ys4[q] = *(const u32x4*)(U + ((size_t)b * S + ((S - s) & (S - 1))) * D + c0); }
#pragma unroll
        for (int q = 0; q < 4; ++q) { const size_t i = i0 + q * NGT; const int c0 = (int)(i & 127) * 8, s = (int)(i >> 7) & 2047, b = (int)(i >> 18);
            const u32x4 x = xs4[q], y = ys4[q];
            const unsigned xs[4] = {x.x, x.y, x.z, x.w}, ys[4] = {y.x, y.y, y.z, y.w}; unsigned ps[4], ms[4];
#pragma unroll
            for (int qq = 0; qq < 4; ++qq) { const float a0 = bf_lo(xs[qq]), a1 = bf_hi(xs[qq]), b0 = s ? bf_lo(ys[qq]) : 0.f, b1 = s ? bf_hi(ys[qq]) : 0.f;
                ps[qq] = cvt_pk_bf16(a0 + b0, a1 + b1); ms[qq] = s ? cvt_pk_bf16(a0 - b0, a1 - b1) : 0u; }
            u32x4 wp, wm; wp.x = ps[0]; wp.y = ps[1]; wp.z = ps[2]; wp.w = ps[3]; wm.x = ms[0]; wm.y = ms[1]; wm.z = ms[2]; wm.w = ms[3];
            g8::stg16_wt(UF + (((size_t)b * 2 + 0) * 2048 + s) * D + c0, wp);
            g8::stg16_wt(UF + (((size_t)b * 2 + 1) * 2048 + s) * D + c0, wm); }
    }
    for (int it = F.gw; it < NB * D; it += F.NGW) {
        const int col = it & 1023, b = it >> 10, g = col >> 8, l = col & 255;
        const u32x2 uw = *(const u32x2*)(U + ((size_t)b * S + 2048) * D + g * 256 + 4 * F.lane); const int cq = 4 * F.lane;
        float acc = __builtin_amdgcn_cosf((float)((l * cq) & 255) * (1.f / 256.f)) * bf_lo(uw.x) + __builtin_amdgcn_cosf((float)((l * (cq + 1)) & 255) * (1.f / 256.f)) * bf_hi(uw.x)
                  + __builtin_amdgcn_cosf((float)((l * (cq + 2)) & 255) * (1.f / 256.f)) * bf_lo(uw.y) + __builtin_amdgcn_cosf((float)((l * (cq + 3)) & 255) * (1.f / 256.f)) * bf_hi(uw.y);
        acc = wave_sum(acc);
        bf16* o = PQ + (size_t)it * KSEQ + 2048;
        if (F.lane < 32) { u32x4 w; w.x = (F.lane == 0) ? cvt_pk_bf16(acc, 0.f) : 0u; w.y = 0u; w.z = 0u; w.w = 0u;
            *(u32x4*)(o + (F.lane < 16 ? 8 * F.lane : KH + 8 * (F.lane - 16))) = w; }
    }
}

__device__ __forceinline__ void ft_unfold_pass(CTXA) {
    CTX_LOCAL();
    const bf16* CS = WSP(bf16, WS_Y); bf16* FO = WSP(bf16, WS_BUFC); const bf16* PQ = WSP(bf16, WS_LA);
    const size_t gt = (size_t)blockIdx.x * NTHREADS + F.tid, NGT = (size_t)F.G * NTHREADS;
    for (size_t i0 = gt; i0 < (size_t)NB * 2048 * (D / 8); i0 += 4 * NGT) {
        u32x4 cv[4], sv[4];
#pragma unroll
        for (int q = 0; q < 4; ++q) { const size_t i = i0 + q * NGT; const int c0 = (int)(i & 127) * 8, k = (int)(i >> 7) & 2047, b = (int)(i >> 18);
            cv[q] = *(const u32x4*)(CS + ((size_t)b * S + k) * D + c0); sv[q] = *(const u32x4*)(CS + ((size_t)b * S + 2048 + k) * D + c0); }
#pragma unroll
        for (int q = 0; q < 4; ++q) { const size_t i = i0 + q * NGT; const int c0 = (int)(i & 127) * 8, k = (int)(i >> 7) & 2047, b = (int)(i >> 18);
            const unsigned cs[4] = {cv[q].x, cv[q].y, cv[q].z, cv[q].w}, ss[4] = {sv[q].x, sv[q].y, sv[q].z, sv[q].w}; unsigned lo[4], hi[4];
#pragma unroll
            for (int qq = 0; qq < 4; ++qq) { const float c0f = bf_lo(cs[qq]), c1f = bf_hi(cs[qq]), s0f = bf_lo(ss[qq]), s1f = bf_hi(ss[qq]); lo[qq] = cvt_pk_bf16(c0f - s0f, c1f - s1f); hi[qq] = cvt_pk_bf16(c0f + s0f, c1f + s1f); }
            u32x4 wl, wh; wl.x = lo[0]; wl.y = lo[1]; wl.z = lo[2]; wl.w = lo[3]; wh.x = hi[0]; wh.y = hi[1]; wh.z = hi[2]; wh.w = hi[3];
            g8::stg16_wt(FO + ((size_t)b * S + k) * D + c0, wl);
            if (k) g8::stg16_wt(FO + ((size_t)b * S + (S - k)) * D + c0, wh); }
    }
    for (int it = F.gw; it < NB * D; it += F.NGW) {
        const int col = it & 1023, b = it >> 10; const bf16* pr = PQ + (size_t)it * KSEQ; float a = 0.f; u32x4 pw[4];
#pragma unroll
        for (int q = 0; q < 4; ++q) pw[q] = *(const u32x4*)(pr + (q * 64 + F.lane) * 8);
        unsigned p2k = (unsigned)pr[2048];
        asm volatile("" : "+v"(pw[0]), "+v"(pw[1]), "+v"(pw[2]), "+v"(pw[3]), "+v"(p2k));
#pragma unroll
        for (int q = 0; q < 4; ++q) { const u32x4 w = pw[q];
            a += (bf_lo(w.x) - bf_hi(w.x)) + (bf_lo(w.y) - bf_hi(w.y)) + (bf_lo(w.z) - bf_hi(w.z)) + (bf_lo(w.w) - bf_hi(w.w)); }
        a = wave_sum(a);
        if (F.lane == 0) { const float p2048 = __uint_as_float(p2k << 16); FO[((size_t)b * S + 2048) * D + col] = (bf16)(cvt_pk_bf16((a + p2048) * (1.f / 1024.f), 0.f) & 0xffffu); }
    }
}

__device__ __forceinline__ void scan_s1(CTXA) {
    CTX_LOCAL();
    const bf16* LA = WSP(bf16, WS_LA); const bf16* BB = WSP(bf16, WS_BB); float* CA = WSP(float, WS_CA); float* CB = WSP(float, WS_CB);
    for (int it = F.gw; it < 2 * NB * 64 * 8; it += F.NGW) {
        const int cg = it & 7, chunk = (it >> 3) & 63, b = (it >> 9) & 3, d = it >> 11;
        const int ch = cg * 128 + 2 * F.lane;
        const size_t e0 = (size_t)d * T * D + ((size_t)b * S + chunk * 64) * D + ch;
        const unsigned* la = (const unsigned*)(LA + e0); const unsigned* bb = (const unsigned*)(BB + e0);
        float A0 = 0.f, A1 = 0.f, B0 = 0.f, B1 = 0.f;
#pragma unroll
        for (int g = 0; g < 4; ++g) { unsigned wl[16], wb[16];
#pragma unroll
            for (int q = 0; q < 16; ++q) { const int tt = g * 16 + q, t = d ? 63 - tt : tt; wl[q] = la[(size_t)t * (D / 2)]; wb[q] = bb[(size_t)t * (D / 2)]; }
#pragma unroll
            for (int q = 0; q < 16; ++q) { const float l0 = bf_lo(wl[q]), l1 = bf_hi(wl[q]);
                A0 += l0; A1 += l1; B0 = __expf(l0) * B0 + bf_lo(wb[q]); B1 = __expf(l1) * B1 + bf_hi(wb[q]); } }
        const size_t o = ((size_t)((d * NB + b) * 64 + chunk)) * D + ch;
        *(f32x2*)(CA + o) = (f32x2){A0, A1}; *(f32x2*)(CB + o) = (f32x2){B0, B1};
    }
}
__device__ __forceinline__ void scan_s3(CTXA) {
    CTX_LOCAL();
    const bf16* LA = WSP(bf16, WS_LA); const bf16* BB = WSP(bf16, WS_BB); const float* CA = WSP(float, WS_CA); const float* CB = WSP(float, WS_CB);
    const bf16* GG = WSP(bf16, WS_BUFA); bf16* Y = WSP(bf16, WS_Y);
    for (int it = F.gw; it < NB * 64 * 8; it += F.NGW) {
        const int cg = it & 7, chunk = (it >> 3) & 63, b = it >> 9;
        const int ch = cg * 128 + 2 * F.lane;
        float hf0 = 0.f, hf1 = 0.f, hb0 = 0.f, hb1 = 0.f;
        for (int c0 = 0; c0 < chunk; c0 += 16) { f32x2 av[16], bv[16];
#pragma unroll
            for (int q = 0; q < 16; ++q) { const int c = c0 + q; const bool ok = c < chunk; const size_t o = ((size_t)((0 * NB + b) * 64 + (ok ? c : 0))) * D + ch;
                av[q] = *(const f32x2*)(CA + o); bv[q] = *(const f32x2*)(CB + o); if (!ok) { av[q] = (f32x2){0.f, 0.f}; bv[q] = (f32x2){0.f, 0.f}; } }
#pragma unroll
            for (int q = 0; q < 16; ++q) { hf0 = __expf(av[q].x) * hf0 + bv[q].x; hf1 = __expf(av[q].y) * hf1 + bv[q].y; } }
        for (int c0 = 63; c0 > chunk; c0 -= 16) { f32x2 av[16], bv[16];
#pragma unroll
            for (int q = 0; q < 16; ++q) { const int c = c0 - q; const bool ok = c > chunk; const size_t o = ((size_t)((1 * NB + b) * 64 + (ok ? c : 63))) * D + ch;
                av[q] = *(const f32x2*)(CA + o); bv[q] = *(const f32x2*)(CB + o); if (!ok) { av[q] = (f32x2){0.f, 0.f}; bv[q] = (f32x2){0.f, 0.f}; } }
#pragma unroll
            for (int q = 0; q < 16; ++q) { hb0 = __expf(av[q].x) * hb0 + bv[q].x; hb1 = __expf(av[q].y) * hb1 + bv[q].y; } }
        const size_t e0 = ((size_t)b * S + chunk * 64) * D + ch;
        const unsigned* la0 = (const unsigned*)(LA + e0); const unsigned* bb0 = (const unsigned*)(BB + e0);
        const unsigned* la1 = (const unsigned*)(LA + (size_t)T * D + e0); const unsigned* bb1 = (const unsigned*)(BB + (size_t)T * D + e0);
        const unsigned* gg = (const unsigned*)(GG + e0); unsigned* yy = (unsigned*)(Y + e0);
        float fv0[64], fv1[64];
#pragma unroll
        for (int g = 0; g < 4; ++g) { unsigned wl[16], wb[16];
#pragma unroll
            for (int q = 0; q < 16; ++q) { const int t = g * 16 + q; wl[q] = la0[(size_t)t * (D / 2)]; wb[q] = bb0[(size_t)t * (D / 2)]; }
#pragma unroll
            for (int q = 0; q < 16; ++q) { const int t = g * 16 + q; hf0 = __expf(bf_lo(wl[q])) * hf0 + bf_lo(wb[q]); hf1 = __expf(bf_hi(wl[q])) * hf1 + bf_hi(wb[q]); fv0[t] = hf0; fv1[t] = hf1; } }
#pragma unroll
        for (int g = 0; g < 4; ++g) { unsigned wl[16], wb[16], wg[16];
#pragma unroll
            for (int q = 0; q < 16; ++q) { const int t = 63 - (g * 16 + q); wl[q] = la1[(size_t)t * (D / 2)]; wb[q] = bb1[(size_t)t * (D / 2)]; wg[q] = gg[(size_t)t * (D / 2)]; }
#pragma unroll
            for (int q = 0; q < 16; ++q) { const int t = 63 - (g * 16 + q); hb0 = __expf(bf_lo(wl[q])) * hb0 + bf_lo(wb[q]); hb1 = __expf(bf_hi(wl[q])) * hb1 + bf_hi(wb[q]);
                yy[(size_t)t * (D / 2)] = cvt_pk_bf16((fv0[t] + hb0) * bf_lo(wg[q]), (fv1[t] + hb1) * bf_hi(wg[q])); } }
    }
}

__device__ __forceinline__ void topk_pass(CTXA) {
    CTX_LOCAL();
    const float* AFF = WSP(float, WS_AFF); float* GATEV = WSP(float, WS_GATEV); int* SLOTOF = WSP(int, WS_SLOTOF);
    LAS unsigned* wcnt = (LAS unsigned*)F.lds;
    LAS unsigned* wtot = (LAS unsigned*)(F.lds + 256);
    int* IDX = WSP(int, WS_IDX);
    for (int pair = blockIdx.x; pair < NB * NE; pair += F.G) {
        const int b = pair >> 4, e = pair & 15;
        const float* aff = AFF + (size_t)pair * S + 8 * F.tid;
        const f32x4 v0 = *(const f32x4*)aff, v1 = *(const f32x4*)(aff + 4);
        float val[8] = {v0[0], v0[1], v0[2], v0[3], v1[0], v1[1], v1[2], v1[3]};
        unsigned key[8];
#pragma unroll
        for (int i = 0; i < 8; ++i) key[i] = __float_as_uint(val[i]);
        unsigned Tk = 0u; int par = 0;
        for (int bit = 30; bit >= 0; --bit) {
            const unsigned cand = Tk | (1u << bit); unsigned c = 0;
#pragma unroll
            for (int i = 0; i < 8; ++i) c += (unsigned)__builtin_popcountll(__ballot(key[i] >= cand));
            if (F.lane == 0) wcnt[par * 8 + F.wave] = c;
            __syncthreads();
            unsigned tot = 0;
#pragma unroll
            for (int w = 0; w < 8; ++w) tot += wcnt[par * 8 + w];
            if (tot >= (unsigned)CAP) Tk = cand;
            par ^= 1;
        }
        int gtc = 0, eqc = 0;
#pragma unroll
        for (int i = 0; i < 8; ++i) { gtc += key[i] > Tk; eqc += key[i] == Tk; }
        int gin = gtc, ein = eqc;
#pragma unroll
        for (int o = 1; o < 64; o <<= 1) { const int g2 = __shfl_up(gin, o), e2 = __shfl_up(ein, o); if (F.lane >= o) { gin += g2; ein += e2; } }
        if (F.lane == 63) { wtot[F.wave] = (unsigned)gin; wtot[8 + F.wave] = (unsigned)ein; }
        __syncthreads();
        int gb = gin - gtc, eb = ein - eqc, ngt = 0;
#pragma unroll
        for (int w = 0; w < 8; ++w) { const int g2 = (int)wtot[w], e2 = (int)wtot[8 + w]; ngt += g2; if (w < F.wave) { gb += g2; eb += e2; } }
        const int need_eq = CAP - ngt, slot0 = (e * NB + b) * CAP;
        int so[8];
#pragma unroll
        for (int i = 0; i < 8; ++i) { const bool g = key[i] > Tk, q = key[i] == Tk; const bool sel = g || (q && eb < need_eq); const int pos = gb + (eb < need_eq ? eb : need_eq);
            if (sel) { IDX[slot0 + pos] = 8 * F.tid + i; GATEV[slot0 + pos] = val[i]; }
            so[i] = sel ? pos : -1; gb += g; eb += q; }
        int* sp = SLOTOF + (size_t)pair * S + 8 * F.tid;
        *(int4*)sp = make_int4(so[0], so[1], so[2], so[3]); *(int4*)(sp + 4) = make_int4(so[4], so[5], so[6], so[7]);
        __syncthreads();
        __syncthreads();
    }
}


__device__ __forceinline__ void combine_pass(CTXA, int layer) {
    CTX_LOCAL();
    bf16* H = WSP(bf16, WS_HB); unsigned char* XN8 = WSP(unsigned char, WS_XN); const unsigned char* YG = WSP(unsigned char, WS_YG); const int* SLOTOF = WSP(int, WS_SLOTOF);
    const float* g = INP(4) + layer * D;
    f32x4 gv[4];
#pragma unroll
    for (int j = 0; j < 4; ++j) gv[j] = *(const f32x4*)(g + 4 * F.lane + 256 * j);
    const int vcu = F.gw / NWAVES, ntrip = ((T / 64 - vcu + F.G - 1) / F.G) * 4;
#define CMB_ROW(tp, rr) ((vcu + ((tp) >> 2) * F.G) * 64 + 8 * F.wave + 2 * ((tp) & 3) + (rr))
    int sln[2];
#pragma unroll
    for (int rr = 0; rr < 2; ++rr) { const int row = CMB_ROW(0, rr); sln[rr] = (ntrip > 0) ? SLOTOF[((size_t)((row >> 12) * NE + (F.lane & 15))) * S + (row & 4095)] : -1; }
    for (int tp = 0; tp < ntrip; ++tp) {
        int sl[2]; f32x4 v[2][4]; unsigned em[2]; unsigned yw[2][4][4]; float wgt[2][4];
#pragma unroll
        for (int rr = 0; rr < 2; ++rr) { const int row = CMB_ROW(tp, rr);
            sl[rr] = sln[rr]; { const int rown = CMB_ROW(tp + 1, rr); sln[rr] = (tp + 1 < ntrip) ? SLOTOF[((size_t)((rown >> 12) * NE + (F.lane & 15))) * S + (rown & 4095)] : -1; }
#pragma unroll
            for (int j = 0; j < 4; ++j) { const u32x2 w = *(const u32x2*)(H + (size_t)row * D + 4 * F.lane + 256 * j); v[rr][j] = (f32x4){bf_lo(w.x), bf_hi(w.x), bf_lo(w.y), bf_hi(w.y)}; } }
#pragma unroll
        for (int rr = 0; rr < 2; ++rr) { const int row = CMB_ROW(tp, rr), b = row >> 12;
            em[rr] = (unsigned)(__ballot(sl[rr] >= 0) & 0xFFFFull);
#pragma unroll
            for (int q = 0; q < 4; ++q) { const bool valid = em[rr] != 0u; const int e = valid ? __builtin_ctz(em[rr]) : 0; em[rr] &= em[rr] - 1u;
                const int se = __builtin_amdgcn_readlane(sl[rr], e); wgt[rr][q] = __builtin_ldexpf(valid ? 1.f : 0.f, -6);
                const unsigned char* y = YG + ((size_t)((e * NB + b) * CAP + (valid ? se : 0))) * D + 4 * F.lane;
#pragma unroll
                for (int j = 0; j < 4; ++j) yw[rr][q][j] = *(const unsigned*)(y + 256 * j); } }
#pragma unroll
        for (int rr = 0; rr < 2; ++rr) { const int row = CMB_ROW(tp, rr), b = row >> 12;
#pragma unroll
            for (int q = 0; q < 4; ++q)
#pragma unroll
                for (int j = 0; j < 4; ++j) { const int w = (int)yw[rr][q][j]; const float g1 = wgt[rr][q];
                    v[rr][j][0] += g1 * __builtin_amdgcn_cvt_f32_fp8(w, 0); v[rr][j][1] += g1 * __builtin_amdgcn_cvt_f32_fp8(w, 1); v[rr][j][2] += g1 * __builtin_amdgcn_cvt_f32_fp8(w, 2); v[rr][j][3] += g1 * __builtin_amdgcn_cvt_f32_fp8(w, 3); }
            unsigned m2 = em[rr];
            while (m2) { const int e = __builtin_ctz(m2); m2 &= m2 - 1u; const int se = __builtin_amdgcn_readlane(sl[rr], e);
                const unsigned char* y = YG + ((size_t)((e * NB + b) * CAP + se)) * D + 4 * F.lane;
#pragma unroll
                for (int j = 0; j < 4; ++j) { const int w = (int)*(const unsigned*)(y + 256 * j); const float g1 = 1.f / 64.f;
                    v[rr][j][0] += g1 * __builtin_amdgcn_cvt_f32_fp8(w, 0); v[rr][j][1] += g1 * __builtin_amdgcn_cvt_f32_fp8(w, 1); v[rr][j][2] += g1 * __builtin_amdgcn_cvt_f32_fp8(w, 2); v[rr][j][3] += g1 * __builtin_amdgcn_cvt_f32_fp8(w, 3); } }
            float ss = 0.f;
#pragma unroll
            for (int j = 0; j < 4; ++j) { u32x2 hw2; hw2.x = cvt_pk_bf16(v[rr][j][0], v[rr][j][1]); hw2.y = cvt_pk_bf16(v[rr][j][2], v[rr][j][3]); *(u32x2*)(H + (size_t)row * D + 4 * F.lane + 256 * j) = hw2; ss += (v[rr][j][0] * v[rr][j][0] + v[rr][j][1] * v[rr][j][1]) + (v[rr][j][2] * v[rr][j][2] + v[rr][j][3] * v[rr][j][3]); }
            const float rs = rsqrtf(wave_sum(ss) * (1.f / D) + EPS);
#pragma unroll
            for (int j = 0; j < 4; ++j) { const f32x4 o = v[rr][j] * rs * gv[j]; *(unsigned*)(XN8 + (size_t)row * D + 4 * F.lane + 256 * j) = pk4_fp8(clamp448(8.f * o[0]), clamp448(8.f * o[1]), clamp448(8.f * o[2]), clamp448(8.f * o[3])); } }
    }
#undef CMB_ROW
}

constexpr int PH_PER_LAYER = 16, PH_FINAL = 1 + DEPTH * PH_PER_LAYER, PH_END = PH_FINAL + 1;
__host__ __device__ inline bool phase_exists(int ph) {
    if (ph == 0 || ph == PH_FINAL) return true;
    if (ph < 0 || ph > PH_FINAL) return false;
    const int l = (ph - 1) / PH_PER_LAYER, k = (ph - 1) % PH_PER_LAYER;
    if (k >= 15 || k == 0) return false;
    if (k == 8) return false;
    if (k == 10) return false;

    return true;
}

__global__ void __launch_bounds__(NTHREADS, 2) mk_fwd(Args args) {
    extern __shared__ __attribute__((aligned(16))) unsigned char lds_raw[];
    LAS unsigned char* const lds = (LAS unsigned char*)lds_raw;
    volatile LAS unsigned* MISC = (volatile LAS unsigned*)(lds + MISC_OFF);
    for (int u = threadIdx.x; u < 256; u += NTHREADS) MISC[u] = 0u;
    __syncthreads();
    const int lo = args.ph_lo, hi = args.ph_hi;
    const bool multi = (hi - lo) > 1;
    const bool grp_ok = multi && gridDim.x == 256u; const int grp_id = (int)(((blockIdx.x & 7u) * 32u + (blockIdx.x >> 3)) >> 2); unsigned grp_uses = 0u;
    if (grp_ok && threadIdx.x == 0) __hip_atomic_store((unsigned*)(args.ws + WS_CTL) + CW_XID + ((blockIdx.x & 7u) * 32u + (blockIdx.x >> 3)), xb_xcc_id() + 1u, __ATOMIC_RELAXED, __HIP_MEMORY_SCOPE_AGENT);
    XcdBarrier bar; bar.bar = (unsigned*)(args.ws + WS_CTL) + CW_BAR; bar.x = 0; bar.st = MISC + 8;
    if (multi) bar = xcd_barrier_post((unsigned*)(args.ws + WS_CTL) + CW_BAR, MISC + 8);

#ifndef PROBE_REPEAT
#define PROBE_REPEAT(ph) 0
#endif
    for (int ph0 = lo, rep = 0; ph0 < hi; ) {
        const int ph = ph0;
        if (rep < PROBE_REPEAT(ph)) ++rep; else { rep = 0; ++ph0; }
        if (!phase_exists(ph)) continue;
        struct { int z; } F; F.z = opaque_zero();
        bool isg = false; g8::Desc gd;
        gd.kind = g8::K_PLAIN; gd.K = D; gd.lda = D; gd.ldb = D; gd.nM = 64; gd.nN = 4; gd.ldo = D; gd.esz = 2; gd.gidx = nullptr; gd.u0 = (int)blockIdx.x; gd.ustride = (int)gridDim.x; gd.grp = 0; gd.sc_w = 0x7F7F7F7F; gd.sc_a = 0x7F7F7F7F; gd.A = nullptr; gd.Bt = nullptr; gd.o0 = nullptr; gd.o1 = nullptr; gd.p0 = nullptr; gd.p1 = nullptr; gd.p2 = nullptr;
        if (ph == 0) p0_prologue(lds, args);
        else if (ph == PH_FINAL) final_pass(lds, args);
        else {
            const int layer = (ph - 1) / PH_PER_LAYER, k = (ph - 1) % PH_PER_LAYER, j = layer >> 1; const bool rg = (layer & 1) == 0;
            switch (k) {
            case 1: isg = true; gd.A = WSP(bf16, WS_HB); gd.grp = grp_ok ? 1 : 0;
                if (rg) { gd.kind = g8::K_RGIN; gd.nN = 8; gd.Bt = WSP(bf16, WS_WINT) + (size_t)j * 2048 * 1024; gd.p0 = INP(7) + (size_t)j * 2048; gd.p1 = WSP(float, WS_SSQ); gd.o0 = WSP(bf16, WS_BUFA); gd.o1 = WSP(bf16, WS_BUFB); }
                else { gd.Bt = WSP(bf16, WS_FTINT) + (size_t)j * 1048576; gd.p0 = WSP(float, WS_SSQ); gd.o0 = WSP(bf16, WS_BUFA); }
                break;
            case 2: if (rg) conv_pass(lds, args, j); else ft_fold_pass(lds, args); break;
            case 3: isg = true;
                if (rg) { gd.kind = g8::K_RGGATE; gd.grp = grp_ok ? 1 : 0; gd.K = 256; gd.lda = D; gd.ldb = 256; gd.nN = 16; gd.A = WSP(bf16, WS_BUFC); gd.Bt = WSP(bf16, WS_GATET) + (size_t)j * 4 * 1024 * 256;
                    gd.p0 = INP(11) + (size_t)j * 2048; gd.p1 = INP(13) + (size_t)j * 2048; gd.p2 = INP(14) + (size_t)j * 2048; gd.o0 = WSP(bf16, WS_LA); gd.o1 = WSP(bf16, WS_BB); }
                else { gd.kind = g8::K_FTCH; gd.K = 256; gd.lda = 256; gd.ldb = D; gd.nM = 32; gd.nN = 8; gd.ldo = KSEQ; gd.A = WSP(bf16, WS_DFTC); gd.Bt = WSP(bf16, WS_BUFB); gd.o0 = WSP(bf16, WS_LA); }
                break;
            case 4: if (rg) scan_s1(lds, args);
                else { isg = true; gd.kind = g8::K_FTSEQ; gd.K = KH; gd.lda = KH; gd.ldb = KSEQ; gd.A = WSP(bf16, WS_DFTS); gd.Bt = WSP(bf16, WS_LA); gd.o0 = WSP(bf16, WS_Y); }
                break;
            case 5: if (rg) scan_s3(lds, args); else ft_unfold_pass(lds, args); break;
            case 6: isg = true; gd.kind = g8::K_RESID; gd.o0 = WSP(bf16, WS_HB); gd.grp = grp_ok ? 1 : 0;
                if (rg) { gd.A = WSP(bf16, WS_Y); gd.Bt = WSP(bf16, WS_WOUTT) + (size_t)j * 1048576; gd.p0 = INP(16) + (size_t)j * D; }
                else { gd.A = WSP(bf16, WS_BUFC); gd.Bt = WSP(bf16, WS_FTOUTT) + (size_t)j * 1048576; }
                break;
            case 7: router_pass(lds, args, layer); break;
            case 9: topk_pass(lds, args);
                isg = true; gd.K = PLE; gd.lda = PLE; gd.ldb = PLE; gd.A = WSP(bf16, WS_PBF) + (size_t)layer * T * PLE; gd.Bt = WSP(bf16, WS_PLEPT) + (size_t)layer * 1024 * 256; gd.o0 = WSP(bf16, WS_PP) + (size_t)layer * T * D;
                { const int npair = NB * NE, G = (int)gridDim.x; if (G > npair) { gd.u0 = (int)blockIdx.x - npair; gd.ustride = G - npair; } }
                break;
            case 11: isg = true; gd.kind = g8::K_FFN1; gd.grp = grp_ok ? 1 : 0; gd.nM = 128; gd.nN = 16; gd.esz = 1; gd.sc_w = 0x76767676; gd.sc_a = 0x7C7C7C7C;
                gd.A = WSP(unsigned char, WS_XN); gd.gidx = WSP(int, WS_IDX); gd.Bt = WSP(unsigned char, WS_W1T) + (size_t)layer * NE * 4096 * 1024; gd.o0 = WSP(unsigned char, WS_HG); break;
            case 12: isg = true; gd.kind = g8::K_FFN2; gd.grp = grp_ok ? 1 : 0; gd.K = FF; gd.lda = FF; gd.ldb = FF; gd.nM = 128; gd.esz = 1; gd.sc_w = 0x76767676; gd.sc_a = 0x7D7D7D7D;
                gd.A = WSP(unsigned char, WS_HG); gd.Bt = WSP(unsigned char, WS_W2T) + (size_t)layer * NE * 1024 * 2048; gd.p0 = WSP(float, WS_GATEV); gd.o0 = WSP(unsigned char, WS_YG); break;
            case 13: combine_pass(lds, args, layer); break;
            case 14: isg = true; gd.kind = g8::K_PLE; gd.esz = 1; gd.grp = grp_ok ? 1 : 0; gd.sc_w = 0x76767676; gd.sc_a = 0x7C7C7C7C; gd.A = WSP(unsigned char, WS_XN); gd.Bt = WSP(unsigned char, WS_PLEGT) + (size_t)layer * 1048576; gd.p0 = WSP(bf16, WS_PP) + (size_t)layer * T * D; gd.p1 = WSP(float, WS_SSQ); gd.o0 = WSP(bf16, WS_HB); break;
            default: break;
            }
        }
        if (isg) { if (gd.esz == 1) g8::gemm_phase<true>(lds, gd); else g8::gemm_phase<false>(lds, gd); }
        if (multi && ph0 < hi) {
            const int kk = (ph >= 1 && ph < PH_FINAL) ? (ph - 1) % PH_PER_LAYER : -1;
            const bool rgl = (((ph - 1) / PH_PER_LAYER) & 1) == 0;
            if (grp_ok && (kk == 6 || kk == 11 || kk == 13 || kk == 14 || (rgl && (kk == 2 || kk == 3 || kk == 5)))) group_barrier((unsigned*)(args.ws + WS_CTL), grp_id, 4u * (++grp_uses), MISC + 12);
            else xcd_barrier(bar);
        }
    }
}

extern "C" void kernel_launch(void* const* d_in, const int* in_sizes, int n_in, void* d_out, int out_size, void* d_ws, size_t ws_size, hipStream_t stream) {
    static int grid = 0;
    if (grid == 0) {
        if (n_in != 25 || in_sizes[0] != T * D || out_size != T * D || ws_size < WS_END) {
            fprintf(stderr, "kernel_launch: unexpected shapes (n_in %d, in0 %d, out %d, ws %zu < %zu); nothing launched\n", n_in, n_in > 0 ? in_sizes[0] : -1, out_size, ws_size, (size_t)WS_END); grid = -1; return; }
        int dev = 0, cus = 0, per_cu = 0;
        if (hipGetDevice(&dev) != hipSuccess || hipDeviceGetAttribute(&cus, hipDeviceAttributeMultiprocessorCount, dev) != hipSuccess) { grid = -1; return; }
        if (hipFuncSetAttribute((const void*)mk_fwd, hipFuncAttributeMaxDynamicSharedMemorySize, LDS_BYTES) != hipSuccess) { fprintf(stderr, "kernel_launch: hipFuncSetAttribute failed\n"); grid = -1; return; }
        if (hipOccupancyMaxActiveBlocksPerMultiprocessor(&per_cu, (const void*)mk_fwd, NTHREADS, LDS_BYTES) != hipSuccess || per_cu < 1)
            fprintf(stderr, "kernel_launch: occupancy query reports %d workgroups per CU\n", per_cu);
        (void)hipGetLastError();
        grid = cus;
    }
    if (grid < 0) return;
    (void)hipMemsetAsync((char*)d_ws + WS_CTL, 0, CTL_ZERO_BYTES, stream);
    Args a{};
    for (int i = 0; i < 25; ++i) a.in[i] = (const float*)d_in[i];
    a.out = (float*)d_out; a.ws = (unsigned char*)d_ws;
#if MK_ONE_LAUNCH
    a.ph_lo = 0; a.ph_hi = PH_END;
    hipLaunchKernelGGL(mk_fwd, dim3(grid), dim3(NTHREADS), LDS_BYTES, stream, a);
#else
    for (int ph = 0; ph < PH_END; ++ph) {
        if (!phase_exists(ph)) continue;
        a.ph_lo = ph; a.ph_hi = ph + 1;
        hipLaunchKernelGGL(mk_fwd, dim3(grid), dim3(NTHREADS), LDS_BYTES, stream, a);
    }
#endif
}
```

```cpp
#include <hip/hip_runtime.h>
#include <cstdio>
#include <cstdint>

#ifndef MK_ONE_LAUNCH
#define MK_ONE_LAUNCH 1
#endif

#define LAS __attribute__((address_space(3)))
typedef unsigned short bf16;
typedef short bf16x8 __attribute__((ext_vector_type(8)));
typedef float f32x4 __attribute__((ext_vector_type(4)));
typedef float f32x2 __attribute__((ext_vector_type(2)));
typedef unsigned u32x2 __attribute__((ext_vector_type(2)));
typedef unsigned u32x4 __attribute__((ext_vector_type(4)));

constexpr int NB = 4, S = 4096, D = 1024, T = NB * S, DEPTH = 4, NE = 16, CAP = 512, FF = 2048, PLE = 256, NSLOT = NE * NB * CAP;
constexpr float EPS = 1e-6f;
constexpr int KH = 2176;
constexpr int KSEQ = 2 * KH;
constexpr int NWAVES = 8, NTHREADS = 512;

constexpr size_t MiB = 1u << 20;
constexpr size_t WS_CTL = 0, CTL_ZERO_BYTES = 1 * MiB;
constexpr size_t WS_W1T = 1 * MiB;
constexpr size_t WS_W2T = WS_W1T + 256 * MiB;
constexpr size_t WS_WINT = WS_W2T + 128 * MiB;
constexpr size_t WS_GATET = WS_WINT + 8 * MiB;
constexpr size_t WS_WOUTT = WS_GATET + 4 * MiB;
constexpr size_t WS_FTINT = WS_WOUTT + 4 * MiB;
constexpr size_t WS_FTOUTT = WS_FTINT + 4 * MiB;
constexpr size_t WS_PLEGT = WS_FTOUTT + 4 * MiB;
constexpr size_t WS_PLEPT = WS_PLEGT + 8 * MiB;
constexpr size_t WS_DFTC = WS_PLEPT + 2 * MiB;
constexpr size_t WS_DFTS = WS_DFTC + 1 * MiB;
constexpr size_t WS_PBF = WS_DFTS + 64 * MiB;
constexpr size_t WS_H = WS_PBF + 32 * MiB;
constexpr size_t WS_XN = WS_H + 64 * MiB;
constexpr size_t WS_BUFA = WS_XN + 32 * MiB;
constexpr size_t WS_BUFB = WS_BUFA + 32 * MiB;
constexpr size_t WS_BUFC = WS_BUFB + 32 * MiB;
constexpr size_t WS_LA = WS_BUFC + 32 * MiB;
constexpr size_t WS_BB = WS_LA + 64 * MiB;
constexpr size_t WS_Y = WS_BB + 64 * MiB;
constexpr size_t WS_CA = WS_Y + 32 * MiB;
constexpr size_t WS_CB = WS_CA + 2 * MiB;
constexpr size_t WS_AFF = WS_CB + 2 * MiB;
constexpr size_t WS_IDX = WS_AFF + 1 * MiB;
constexpr size_t WS_GATEV = WS_IDX + 1 * MiB;
constexpr size_t WS_SLOTOF = WS_GATEV + 1 * MiB;
constexpr size_t WS_XG = WS_SLOTOF + 1 * MiB;
constexpr size_t WS_HG = WS_XG + 64 * MiB;
constexpr size_t WS_YG = WS_HG + 128 * MiB;
constexpr size_t WS_PP = WS_YG + 64 * MiB;
constexpr size_t WS_HB = WS_PP + 128 * MiB;
constexpr size_t WS_SSQ = WS_HB + 32 * MiB;
constexpr size_t WS_END = WS_SSQ + 1 * MiB;

constexpr int CW_BAR = 4096;

constexpr int RING_BYTES = 131072;
constexpr int MISC_OFF = RING_BYTES;
constexpr int LDS_BYTES = 147456;

__device__ __forceinline__ unsigned cvt_pk_bf16(float lo, float hi) { unsigned r; asm("v_cvt_pk_bf16_f32 %0, %1, %2" : "=v"(r) : "v"(lo), "v"(hi)); return r; }
__device__ __forceinline__ float bf_lo(unsigned w) { return __uint_as_float(w << 16); }
__device__ __forceinline__ float bf_hi(unsigned w) { return __uint_as_float(w & 0xffff0000u); }
__device__ __forceinline__ float wave_sum(float v) {
#pragma unroll
    for (int o = 1; o < 64; o <<= 1) v += __shfl_xor(v, o);
    return v;
}
__device__ __forceinline__ float sigmoidf_(float x) { return __builtin_amdgcn_rcpf(1.f + __expf(-x)); }
constexpr float L2E = 1.4426950408889634f;
__device__ __forceinline__ float gelu_tanh(float x) {
    const float C0 = 2.f * 0.7978845608028654f * L2E, C1 = 2.f * 0.7978845608028654f * 0.044715f * L2E;
    const float e = __builtin_amdgcn_exp2f(x * __builtin_fmaf(x * x, C1, C0));
    return __builtin_fmaf(-x, __builtin_amdgcn_rcpf(1.f + e), x);
}
__device__ __forceinline__ unsigned pk4_fp8(float a, float b, float c, float d) { int w = 0; w = __builtin_amdgcn_cvt_pk_fp8_f32(a, b, w, false); w = __builtin_amdgcn_cvt_pk_fp8_f32(c, d, w, true); return (unsigned)w; }
__device__ __forceinline__ float clamp448(float x) { return __builtin_amdgcn_fmed3f(x, -448.f, 448.f); }
#define VM_WAIT() asm volatile("s_waitcnt vmcnt(0)" ::: "memory")
#define LDS_WAIT() asm volatile("s_waitcnt lgkmcnt(0)" ::: "memory")

#define XB_TMO      128
#define XB_XCNT(j)  (256  + 64 * (j))
#define XB_XSUB(j)  (1280 + 64 * (j))
#define XB_XGEN(j)  (2304 + 64 * (j))
#define XB_TOP      3328
#define XB_TOPGEN   3392
#define XCD_BAR_WORDS 3456
#define XB_SPIN_CAP (1u << 18)

__device__ __forceinline__ unsigned xb_ld(unsigned* p)              { return __hip_atomic_load(p, __ATOMIC_RELAXED, __HIP_MEMORY_SCOPE_AGENT); }
__device__ __forceinline__ unsigned xb_add(unsigned* p, unsigned v) { return __hip_atomic_fetch_add(p, v, __ATOMIC_RELAXED, __HIP_MEMORY_SCOPE_AGENT); }
__device__ __forceinline__ unsigned xb_xcc_id() { return (unsigned)__builtin_amdgcn_s_getreg((3 << 11) | 20) & 0xFu; }
#define XB_SPIN(cond, bar) do { unsigned _sp = 0; while (cond) { __builtin_amdgcn_s_sleep(1); \
    if ((++_sp & 255u) == 0u) { if (xb_ld(&(bar)[XB_TMO])) break; if (_sp > XB_SPIN_CAP) { atomicAdd(&(bar)[XB_TMO], 1u); break; } } } } while (0)

struct XcdBarrier { unsigned* bar; unsigned x; volatile LAS unsigned* st; };

__device__ __forceinline__ XcdBarrier xcd_barrier_post(unsigned* bar, volatile LAS unsigned* st) {
    XcdBarrier b; b.bar = bar; b.x = xb_xcc_id(); b.st = st;
    if (threadIdx.x == 0) (void)xb_add(&bar[XB_XCNT(b.x)], 1u);
    return b;
}
__device__ __forceinline__ void xcd_barrier_complete(unsigned* bar, unsigned x, unsigned& nloc, unsigned& nx) {
    const unsigned G = gridDim.x * gridDim.y * gridDim.z;
    unsigned sum, cnt, mine, sp = 0u;
    for (;;) {
        sum = 0u; cnt = 0u; mine = 0u;
#pragma unroll
        for (unsigned j = 0; j < 16; ++j) { const unsigned c = xb_ld(&bar[XB_XCNT(j)]); sum += c; cnt += (c > 0u) ? 1u : 0u; mine = (j == x) ? c : mine; }
        if (sum == G) break;
        __builtin_amdgcn_s_sleep(1);
        if ((++sp & 255u) == 0u) { if (xb_ld(&bar[XB_TMO])) break; if (sp > XB_SPIN_CAP) { atomicAdd(&bar[XB_TMO], 1u); break; } }
    }
    nloc = mine > 0u ? mine : 1u; nx = cnt > 0u ? cnt : 1u;
}
__device__ __forceinline__ void xcd_barrier(const XcdBarrier& b) {
    asm volatile("s_waitcnt vmcnt(0)" ::: "memory");
    __syncthreads();
    if (threadIdx.x == 0) {
        unsigned* bar = b.bar;
        __builtin_amdgcn_s_waitcnt(0);
        unsigned nloc = b.st[0], nx = b.st[1];
        if (nloc == 0u) { xcd_barrier_complete(bar, b.x, nloc, nx); b.st[0] = nloc; b.st[1] = nx; }
        const unsigned old = xb_add(&bar[XB_XSUB(b.x)], 1u);
        const unsigned gen = old / nloc;
        if (old + 1u == (gen + 1u) * nloc) {
            __builtin_amdgcn_fence(__ATOMIC_RELEASE, "agent");
            asm volatile("s_waitcnt vmcnt(0)" ::: "memory");
            const unsigned og = xb_add(&bar[XB_TOP], 1u);
            const unsigned tg = og / nx;
            if (og + 1u == (tg + 1u) * nx) xb_add(&bar[XB_TOPGEN], 1u);
            else XB_SPIN(xb_ld(&bar[XB_TOPGEN]) == tg, bar);
            __builtin_amdgcn_fence(__ATOMIC_ACQUIRE, "agent");
            xb_add(&bar[XB_XGEN(b.x)], 1u);
            asm volatile("s_waitcnt vmcnt(0)" ::: "memory");
        } else {
            __builtin_amdgcn_fence(__ATOMIC_ACQUIRE, "agent");
            XB_SPIN(xb_ld(&bar[XB_XGEN(b.x)]) == gen, bar);
            asm volatile("s_waitcnt vmcnt(0)" ::: "memory");
        }
    }
    __syncthreads();
}

constexpr int CW_GRP = 16384, CW_XID = 20480;
__device__ __forceinline__ void group_barrier(unsigned* ctl, int group, unsigned target, volatile LAS unsigned* st) {
    asm volatile("s_waitcnt vmcnt(0)" ::: "memory");
    __syncthreads();
    if (threadIdx.x == 0) {
        unsigned* c = ctl + CW_GRP + group * 16; unsigned* bar = ctl + CW_BAR;
        unsigned same = st[0];
        if (same == 0u) { unsigned* xi = ctl + CW_XID + group * 4; const unsigned i0 = xb_ld(xi), i1 = xb_ld(xi + 1), i2 = xb_ld(xi + 2), i3 = xb_ld(xi + 3); same = (i0 != 0u && i0 == i1 && i0 == i2 && i0 == i3) ? 2u : 1u; st[0] = same; }
        if (same == 2u) __builtin_amdgcn_fence(__ATOMIC_RELEASE, "workgroup"); else __builtin_amdgcn_fence(__ATOMIC_RELEASE, "agent");
        asm volatile("s_waitcnt vmcnt(0)" ::: "memory");
        (void)xb_add(c, 1u);
        __builtin_amdgcn_fence(__ATOMIC_ACQUIRE, "agent");
        XB_SPIN(xb_ld(c) < target, bar);
        asm volatile("s_waitcnt vmcnt(0)" ::: "memory");
    }
    __syncthreads();
}

namespace g8 {
constexpr int BM = 256, BK = 64, HALF = 128, HTB = HALF * BK * 2, STAGE_BYTES = 8 * HTB;
__device__ __forceinline__ int lds_byte(int r, int c) { const int st = (r >> 4) * 2 + (c >> 5), rr = r & 15, cc = c & 31, ob = rr * 64 + cc * 2; return st * 1024 + (ob ^ (((ob >> 9) & 1) << 5)); }
__device__ __forceinline__ int perm32(int rho) { const int n = rho >> 4, i = rho & 15; return 8 * (i >> 2) + 4 * n + (i & 3); }
__device__ __forceinline__ void stage_rc(int b, int& R, int& C) { const int st = b / 1024, sb = b % 1024, swz = sb ^ (((sb >> 9) & 1) << 5); R = (st >> 1) * 16 + swz / 64; C = (st & 1) * 32 + (swz % 64) / 2; }

enum Kind { K_RGIN = 0, K_RGGATE, K_RESID, K_PLAIN, K_FTCH, K_FTSEQ, K_FFN1, K_FFN2, K_PLE, K_PP };
struct Desc {
    int kind, K, lda, ldb, nM, nN, ldo, esz;
    const int* gidx;
    int u0, ustride;
    int grp;
    int sc_w, sc_a;
    const void* A; const void* Bt;
    void* o0; void* o1;
    const void* p0; const void* p1; const void* p2;
};
struct Tile { const char* a; const char* b; int pm, pn; };

__device__ __forceinline__ bool get_tile(const Desc& d, int i, Tile& t) {
    const int nunits = d.nM * d.nN;
    int pm, pn;
    if (d.grp) { const int bx = d.u0, v = (bx & 7) * 32 + (bx >> 3), q4 = d.nN >> 2, lg = q4 >> 1;
        if (i >= q4 * (d.nM >> 6)) return false;
        pm = (v >> 2) + 64 * (i >> lg); pn = (v & 3) + 4 * (i & (q4 - 1)); }
    else {
    const long L = (long)i * d.ustride + d.u0; if (d.u0 < 0 || L >= nunits) return false;
    int w = (int)L; { const int q = nunits / 8, r = nunits % 8, xcd = w % 8, off = w / 8; w = (xcd < r ? xcd * (q + 1) : r * (q + 1) + (xcd - r) * q) + off; }
    const int nig = 8 * d.nN, gid = w / nig, fm = gid * 8, gsz = (d.nM - fm) < 8 ? (d.nM - fm) : 8;
    pm = fm + ((w % nig) % gsz); pn = (w % nig) / gsz; }
    t.pm = pm; t.pn = pn;
    size_t arow = (size_t)pm * 256, acol = 0, brow = (size_t)pn * 256, bcol = 0;
    switch (d.kind) {
        case K_RGGATE: acol = (size_t)(pn >> 2) * 256; break;
        case K_FTCH:   arow = (size_t)(pm & 1) * 256; brow = ((size_t)(pm >> 3) * 2 + (pm & 1)) * 2048 + (size_t)pn * 256; bcol = (size_t)((pm >> 1) & 3) * 256; break;
        case K_FTSEQ:  arow = (size_t)(pm & 15) * 256; brow = (size_t)(pm >> 4) * 1024 + (size_t)pn * 256; bcol = ((pm & 15) >= 8) ? (size_t)KH : 0; break;
        case K_FFN1:   brow = (size_t)(pm >> 3) * 4096 + (size_t)pn * 256; break;
        case K_FFN2:   brow = (size_t)(pm >> 3) * 1024 + (size_t)pn * 256; break;
        case K_PP:     brow = (size_t)(pm >> 6) * 1024 + (size_t)pn * 256; break;
        default: break;
    }
    t.a = (const char*)d.A + (arow * d.lda + acol) * d.esz; t.b = (const char*)d.Bt + (brow * d.ldb + bcol) * d.esz;
    return true;
}

typedef f32x4 Acc[2][2][4][2];
__device__ __forceinline__ void load_bf16x8(const bf16* p, f32x4& v0, f32x4& v1) { const u32x4 w = *(const u32x4*)p; v0 = (f32x4){bf_lo(w.x), bf_hi(w.x), bf_lo(w.y), bf_hi(w.y)}; v1 = (f32x4){bf_lo(w.z), bf_hi(w.z), bf_lo(w.w), bf_hi(w.w)}; }
__device__ __forceinline__ void store_bf16x8(bf16* p, const f32x4 v0, const f32x4 v1) { u32x4 w; w.x = cvt_pk_bf16(v0[0], v0[1]); w.y = cvt_pk_bf16(v0[2], v0[3]); w.z = cvt_pk_bf16(v1[0], v1[1]); w.w = cvt_pk_bf16(v1[2], v1[3]); *(u32x4*)p = w; }
__device__ __forceinline__ void stg16_wt(void* p, const u32x4 w) { asm volatile("global_store_dwordx4 %0, %1, off sc1\n\ts_nop 1" :: "v"(p), "v"(w) : "memory"); }
__device__ __forceinline__ void store_bf16x8_wt(bf16* p, const f32x4 v0, const f32x4 v1) { u32x4 w; w.x = cvt_pk_bf16(v0[0], v0[1]); w.y = cvt_pk_bf16(v0[2], v0[3]); w.z = cvt_pk_bf16(v1[0], v1[1]); w.w = cvt_pk_bf16(v1[2], v1[3]); stg16_wt(p, w); }
__device__ __forceinline__ void store_bf16x4(bf16* p, const f32x4 v) { u32x2 w; w.x = cvt_pk_bf16(v[0], v[1]); w.y = cvt_pk_bf16(v[2], v[3]); *(u32x2*)p = w; }

__device__ __forceinline__ void rows_rs(const float* ssq, int row0, int fq, float (&rs)[2][4]) {
    f32x4 p[2][4];
#pragma unroll
    for (int ai = 0; ai < 2; ++ai)
#pragma unroll
        for (int m = 0; m < 4; ++m) p[ai][m] = *(const f32x4*)(ssq + (size_t)(row0 + ai * 128 + m * 16) * 16 + 4 * fq);
#pragma unroll
    for (int ai = 0; ai < 2; ++ai)
#pragma unroll
        for (int m = 0; m < 4; ++m) { float s = (p[ai][m][0] + p[ai][m][1]) + (p[ai][m][2] + p[ai][m][3]); s += __shfl_xor(s, 16); s += __shfl_xor(s, 32); rs[ai][m] = rsqrtf(s * (1.f / D) + EPS); }
}
#define EPI_FP8_CASES \
    case K_FFN1: { \
        unsigned char* O = (unsigned char*)d.o0 + (size_t)(u.pm * 256 + lr0) * FF + u.pn * 128 + lc0; \
_Pragma("unroll") \
        for (int ai = 0; ai < 2; ++ai) \
_Pragma("unroll") \
            for (int m = 0; m < 4; ++m) \
                { u32x2 w8; \
_Pragma("unroll") \
                for (int n = 0; n < 2; ++n) { const f32x4 g = acc[ai][0][m][n], up = acc[ai][1][m][n]; f32x4 o; \
_Pragma("unroll") \
                    for (int j = 0; j < 4; ++j) o[j] = clamp448((g[j] * up[j]) * __builtin_amdgcn_rcpf(1.f + __builtin_amdgcn_exp2f(g[j]))); \
                    if (n == 0) w8.x = pk4_fp8(o[0], o[1], o[2], o[3]); else w8.y = pk4_fp8(o[0], o[1], o[2], o[3]); } \
                *(u32x2*)(O + (size_t)(ai * 128 + m * 16) * FF) = w8; } \
    } break; \
    case K_FFN2: { \
        const int row0 = u.pm * 256 + lr0; const float* gatev = (const float*)d.p0; unsigned char* O = (unsigned char*)d.o0 + (size_t)row0 * D + u.pn * 256 + lc0; \
        float gv[2][4]; \
_Pragma("unroll") \
        for (int ai = 0; ai < 2; ++ai) \
_Pragma("unroll") \
            for (int m = 0; m < 4; ++m) gv[ai][m] = gatev[row0 + ai * 128 + m * 16]; \
        asm volatile("" : "+v"(gv[0][0]), "+v"(gv[0][1]), "+v"(gv[0][2]), "+v"(gv[0][3]), "+v"(gv[1][0]), "+v"(gv[1][1]), "+v"(gv[1][2]), "+v"(gv[1][3])); \
_Pragma("unroll") \
        for (int ai = 0; ai < 2; ++ai) \
_Pragma("unroll") \
            for (int m = 0; m < 4; ++m) gv[ai][m] *= 64.f; \
_Pragma("unroll") \
        for (int ai = 0; ai < 2; ++ai) \
_Pragma("unroll") \
            for (int m = 0; m < 4; ++m) \
_Pragma("unroll") \
                for (int bj = 0; bj < 2; ++bj) { const f32x4 y0 = acc[ai][bj][m][0] * gv[ai][m], y1 = acc[ai][bj][m][1] * gv[ai][m]; u32x2 w8; \
                    w8.x = pk4_fp8(clamp448(y0[0]), clamp448(y0[1]), clamp448(y0[2]), clamp448(y0[3])); w8.y = pk4_fp8(clamp448(y1[0]), clamp448(y1[1]), clamp448(y1[2]), clamp448(y1[3])); \
                    *(u32x2*)(O + (size_t)(ai * 128 + m * 16) * D + bj * 128) = w8; } \
    } break; \
    case K_PLE: { \
        const size_t o0 = (size_t)(u.pm * 256 + lr0) * D + u.pn * 256 + lc0; bf16* H = (bf16*)d.o0; const bf16* PP = (const bf16*)d.p0; float* ssq = (float*)d.p1; \
_Pragma("unroll") \
        for (int ai = 0; ai < 2; ++ai) \
_Pragma("unroll") \
            for (int mp = 0; mp < 2; ++mp) { u32x4 hw[2][2], pw[2][2]; \
_Pragma("unroll") \
              for (int mm = 0; mm < 2; ++mm) \
_Pragma("unroll") \
                for (int bj = 0; bj < 2; ++bj) { const size_t ro = o0 + (size_t)(ai * 128 + (2 * mp + mm) * 16) * D + bj * 128; hw[mm][bj] = *(const u32x4*)(H + ro); pw[mm][bj] = *(const u32x4*)(PP + ro); } \
              asm volatile("" : "+v"(hw[0][0]), "+v"(hw[0][1]), "+v"(hw[1][0]), "+v"(hw[1][1]), "+v"(pw[0][0]), "+v"(pw[0][1]), "+v"(pw[1][0]), "+v"(pw[1][1])); \
_Pragma("unroll") \
              for (int mm = 0; mm < 2; ++mm) { const int m = 2 * mp + mm; \
                float part = 0.f; \
_Pragma("unroll") \
                for (int bj = 0; bj < 2; ++bj) { const size_t ro = o0 + (size_t)(ai * 128 + m * 16) * D + bj * 128; const f32x4 a0 = acc[ai][bj][m][0], a1 = acc[ai][bj][m][1]; const u32x4 hh = hw[mm][bj], pp = pw[mm][bj]; f32x4 h0, h1; \
                    h0[0] = bf_lo(hh.x) + sigmoidf_(a0[0]) * bf_lo(pp.x); h0[1] = bf_hi(hh.x) + sigmoidf_(a0[1]) * bf_hi(pp.x); h0[2] = bf_lo(hh.y) + sigmoidf_(a0[2]) * bf_lo(pp.y); h0[3] = bf_hi(hh.y) + sigmoidf_(a0[3]) * bf_hi(pp.y); \
                    h1[0] = bf_lo(hh.z) + sigmoidf_(a1[0]) * bf_lo(pp.z); h1[1] = bf_hi(hh.z) + sigmoidf_(a1[1]) * bf_hi(pp.z); h1[2] = bf_lo(hh.w) + sigmoidf_(a1[2]) * bf_lo(pp.w); h1[3] = bf_hi(hh.w) + sigmoidf_(a1[3]) * bf_hi(pp.w); \
                    store_bf16x8(H + ro, h0, h1); part += ((h0[0] * h0[0] + h0[1] * h0[1]) + (h0[2] * h0[2] + h0[3] * h0[3])) + ((h1[0] * h1[0] + h1[1] * h1[1]) + (h1[2] * h1[2] + h1[3] * h1[3])); } \
                part += __shfl_xor(part, 16); part += __shfl_xor(part, 32); \
                if (fq == 0) ssq[(size_t)(u.pm * 256 + lr0 + ai * 128 + m * 16) * 16 + u.pn * 4 + wc] = part; } } \
    } break;

template <bool FP8>
__device__ __forceinline__ void epilogue(const Desc& d, const Acc& acc, const Tile& u) {
    int tz = threadIdx.x; asm volatile("" : "+v"(tz));
    const int wid = tz >> 6, lane = tz & 63, wr = wid >> 2, wc = wid & 3, fr = lane & 15, fq = lane >> 4;
    const int lr0 = wr * 64 + fr, lc0 = wc * 32 + 8 * fq;
    if constexpr (FP8) {
    switch (d.kind) {
    EPI_FP8_CASES
    default: break;
    }
    } else {
    switch (d.kind) {
    case K_RGIN: {
        const int row0 = u.pm * 256 + lr0, col0 = u.pn * 256 + lc0; const bool isg = u.pn < 4;
        bf16* O = isg ? (bf16*)d.o0 : (bf16*)d.o1; const int oc0 = isg ? col0 : col0 - 1024; const float* bias = (const float*)d.p0; const float* ssq = (const float*)d.p1;
        float rs[2][4]; f32x4 bv[2][2];
        rows_rs(ssq, row0, fq, rs);
#pragma unroll
        for (int bj = 0; bj < 2; ++bj)
#pragma unroll
            for (int n = 0; n < 2; ++n) bv[bj][n] = *(const f32x4*)(bias + col0 + bj * 128 + n * 4);
#pragma unroll
        for (int ai = 0; ai < 2; ++ai)
#pragma unroll
            for (int m = 0; m < 4; ++m)
#pragma unroll
                for (int bj = 0; bj < 2; ++bj) { f32x4 v[2];
#pragma unroll
                    for (int n = 0; n < 2; ++n) { v[n] = acc[ai][bj][m][n] * rs[ai][m] + bv[bj][n];
                        if (isg) { v[n][0] = gelu_tanh(v[n][0]); v[n][1] = gelu_tanh(v[n][1]); v[n][2] = gelu_tanh(v[n][2]); v[n][3] = gelu_tanh(v[n][3]); } }
                    store_bf16x8_wt(O + (size_t)(row0 + ai * 128 + m * 16) * D + oc0 + bj * 128, v[0], v[1]); }
    } break;
    case K_RGGATE: {
        const int head = u.pn >> 2, q = u.pn & 3, dr = q >> 1, c2 = q & 1;
        const int row0 = u.pm * 256 + lr0, ch0 = head * 256 + c2 * 128 + lc0;
        const float* gxb = (const float*)d.p0 + dr * 1024; const float* gab = (const float*)d.p1 + dr * 1024; const float* lam = (const float*)d.p2 + dr * 1024;
        bf16* la = (bf16*)d.o0 + (size_t)dr * T * D; bf16* bb = (bf16*)d.o1 + (size_t)dr * T * D; const bf16* UF = (const bf16*)d.A;
        f32x4 nbx[2], nba[2], sp[2], sp2[2];
#pragma unroll
        for (int n = 0; n < 2; ++n) { const f32x4 bx = *(const f32x4*)(gxb + ch0 + 4 * n), ba = *(const f32x4*)(gab + ch0 + 4 * n), lm = *(const f32x4*)(lam + ch0 + 4 * n);
#pragma unroll
            for (int j = 0; j < 4; ++j) { const float y = __expf(-lm[j]); sp[n][j] = -8.f * ((y < 0.03f) ? y * (1.f + y * (-0.5f + y * ((1.f / 3.f) - 0.25f * y))) : logf(1.f + y));
                sp2[n][j] = 2.f * L2E * sp[n][j]; nbx[n][j] = -L2E * bx[j]; nba[n][j] = -L2E * ba[j]; } }
#pragma unroll
        for (int ai = 0; ai < 2; ++ai) { u32x4 uw[4];
#pragma unroll
            for (int m = 0; m < 4; ++m) uw[m] = *(const u32x4*)(UF + (size_t)(row0 + ai * 128 + m * 16) * D + ch0);
#pragma unroll
            for (int m = 0; m < 4; ++m) { const size_t ro = (size_t)(row0 + ai * 128 + m * 16) * D + ch0;
                const float uf[2][4] = {{bf_lo(uw[m].x), bf_hi(uw[m].x), bf_lo(uw[m].y), bf_hi(uw[m].y)}, {bf_lo(uw[m].z), bf_hi(uw[m].z), bf_lo(uw[m].w), bf_hi(uw[m].w)}};
                f32x4 lo[2], bo[2];
#pragma unroll
                for (int n = 0; n < 2; ++n)
#pragma unroll
                    for (int j = 0; j < 4; ++j) {
                        const float it = __builtin_amdgcn_rcpf(1.f + __builtin_amdgcn_exp2f(__builtin_fmaf(acc[ai][0][m][n][j], -L2E, nbx[n][j])));
                        const float rt = __builtin_amdgcn_rcpf(1.f + __builtin_amdgcn_exp2f(__builtin_fmaf(acc[ai][1][m][n][j], -L2E, nba[n][j])));
                        const float em = 1.f - __builtin_amdgcn_exp2f(sp2[n][j] * rt);
                        lo[n][j] = sp[n][j] * rt; bo[n][j] = __builtin_amdgcn_sqrtf(em) * (it * uf[n][j]); }
                store_bf16x8(la + ro, lo[0], lo[1]); store_bf16x8(bb + ro, bo[0], bo[1]); } }
    } break;
    case K_RESID: {
        const int row0 = u.pm * 256 + lr0, col0 = u.pn * 256 + lc0; bf16* H = (bf16*)d.o0; const float* bias = (const float*)d.p0;
        f32x4 bv[2][2];
#pragma unroll
        for (int bj = 0; bj < 2; ++bj)
#pragma unroll
            for (int n = 0; n < 2; ++n) bv[bj][n] = bias ? *(const f32x4*)(bias + col0 + bj * 128 + n * 4) : (f32x4){0.f, 0.f, 0.f, 0.f};
#pragma unroll
        for (int ai = 0; ai < 2; ++ai) { u32x4 hw[4][2];
#pragma unroll
            for (int m = 0; m < 4; ++m)
#pragma unroll
                for (int bj = 0; bj < 2; ++bj) hw[m][bj] = *(const u32x4*)(H + (size_t)(row0 + ai * 128 + m * 16) * D + col0 + bj * 128);
            asm volatile("" : "+v"(hw[0][0]), "+v"(hw[0][1]), "+v"(hw[1][0]), "+v"(hw[1][1]), "+v"(hw[2][0]), "+v"(hw[2][1]), "+v"(hw[3][0]), "+v"(hw[3][1]));
#pragma unroll
            for (int m = 0; m < 4; ++m)
#pragma unroll
                for (int bj = 0; bj < 2; ++bj) { const u32x4 w = hw[m][bj]; const f32x4 h0 = {bf_lo(w.x), bf_hi(w.x), bf_lo(w.y), bf_hi(w.y)}, h1 = {bf_lo(w.z), bf_hi(w.z), bf_lo(w.w), bf_hi(w.w)};
                    store_bf16x8(H + (size_t)(row0 + ai * 128 + m * 16) * D + col0 + bj * 128, h0 + acc[ai][bj][m][0] + bv[bj][0], h1 + acc[ai][bj][m][1] + bv[bj][1]); } }
    } break;
    case K_PLAIN: case K_FTCH: case K_FTSEQ: case K_PP: {
        int orow = u.pm * 256, ocol = u.pn * 256;
        if (d.kind == K_FTCH) { orow = (u.pm >> 1) * 256; ocol = (u.pm & 1) * KH + u.pn * 256; }
        bf16* O = (bf16*)d.o0 + (size_t)(orow + lr0) * d.ldo + ocol + lc0; const float* ssq = (const float*)d.p0;
        float rs[2][4];
        if (ssq) rows_rs(ssq, orow + lr0, fq, rs);
        else {
#pragma unroll
            for (int ai = 0; ai < 2; ++ai)
#pragma unroll
                for (int m = 0; m < 4; ++m) rs[ai][m] = 1.f; }
#pragma unroll
        for (int ai = 0; ai < 2; ++ai)
#pragma unroll
            for (int m = 0; m < 4; ++m)
#pragma unroll
                for (int bj = 0; bj < 2; ++bj) store_bf16x8_wt(O + (size_t)(ai * 128 + m * 16) * d.ldo + bj * 128, acc[ai][bj][m][0] * rs[ai][m], acc[ai][bj][m][1] * rs[ai][m]);
    } break;
    default: break;
    }
    }
}
#undef EPI_FP8_CASES

typedef int i32x8 __attribute__((ext_vector_type(8)));
typedef int i32x4 __attribute__((ext_vector_type(4)));
template <bool FP8>
__device__ __forceinline__ void gemm_phase(LAS unsigned char* lds, const Desc& prob) {
    int tid = threadIdx.x; asm volatile("" : "+v"(tid));
    const int wid = __builtin_amdgcn_readfirstlane(tid >> 6), lane = tid & 63, wr = wid >> 2, wc = wid & 3, fr = lane & 15, fq = lane >> 4;
    const int esz = FP8 ? 1 : 2;
    const int nt = prob.K * esz / 128;
    int sc_w = prob.sc_w, sc_a = prob.sc_a; asm volatile("" : "+v"(sc_w), "+v"(sc_a));
    unsigned voffA[2], voffB[2];
#pragma unroll
    for (int i = 0; i < 2; ++i) { int R, C; stage_rc(tid * 16 + i * 8192, R, C); const int Rb = (R & ~31) + perm32(R & 31);
        voffA[i] = (unsigned)(R * prob.lda * esz + C * 2); voffB[i] = (unsigned)(Rb * prob.ldb * esz + C * 2); }
    const size_t kstep = 128;
    const size_t hstepA = (size_t)HALF * prob.lda * esz, hstepB = (size_t)HALF * prob.ldb * esz;
    const unsigned ldsw = (unsigned)wid * 1024u;
    const int aoff = lds_byte(wr * 64 + fr, fq * 8), boff = lds_byte(wc * 32 + fr, fq * 8);
    LAS unsigned* const rtab = (LAS unsigned*)(lds + STAGE_BYTES + 1024);
    unsigned goffC[2][2] = {{0u, 0u}, {0u, 0u}}, goffN[2][2] = {{0u, 0u}, {0u, 0u}}; int gR0 = 0; unsigned gC2 = 0u;
    const bool GAT = FP8 && prob.gidx != nullptr;
    if (GAT) {
        int grow[4], gval[4];
#pragma unroll
        for (int q = 0; q < 4; ++q) { const int uu = __builtin_amdgcn_readfirstlane((tid >> 8) + 2 * q), r = tid & 255; Tile tt;
            grow[q] = get_tile(prob, uu, tt) ? tt.pm * 256 + r : -1; gval[q] = prob.gidx[grow[q] < 0 ? 0 : grow[q]]; }
        asm volatile("" : "+v"(gval[0]), "+v"(gval[1]), "+v"(gval[2]), "+v"(gval[3]));
#pragma unroll
        for (int q = 0; q < 4; ++q) { const int uu = __builtin_amdgcn_readfirstlane((tid >> 8) + 2 * q), r = tid & 255;
            if (grow[q] >= 0) rtab[uu * 256 + r] = (unsigned)(((grow[q] >> 9) & 3) * 4096 + gval[q]) * (unsigned)prob.lda; }
        __syncthreads();
        { int R, C; stage_rc(tid * 16, R, C); gR0 = R; gC2 = (unsigned)(C * 2); }
    }
#define G8_GOFF(dst, uord) do { _Pragma("unroll") for (int _h = 0; _h < 2; ++_h) _Pragma("unroll") for (int _i = 0; _i < 2; ++_i) dst[_h][_i] = rtab[((uord) & 7) * 256 + _h * 128 + gR0 + 64 * _i] + gC2; } while (0)
#define G8_STGA(bufoff, h, nx, ptr, kb) do { if (GAT) { _Pragma("unroll") for (int _i = 0; _i < 2; ++_i) { const unsigned _o = ((nx) ? goffN[h][_i] : goffC[h][_i]) + (unsigned)(kb); \
            __builtin_amdgcn_global_load_lds((const unsigned*)((const char*)prob.A + _o), (LAS unsigned*)(lds + (bufoff) + ldsw + _i * 8192), 16, 0, 0); } } \
        else { G8_STAGE(bufoff, (ptr) + ((h) ? hstepA : 0), voffA); } } while (0)
#define G8_SA(b, h) (((b) * 2 + (h)) * HTB)
#define G8_SB(b, h) ((4 + (b) * 2 + (h)) * HTB)
#define G8_STAGE(bufoff, gbase, voff) do { _Pragma("unroll") for (int _i = 0; _i < 2; ++_i) \
        __builtin_amdgcn_global_load_lds((const unsigned*)((const char*)(gbase) + (voff)[_i]), (LAS unsigned*)(lds + (bufoff) + ldsw + _i * 8192), 16, 0, 0); } while (0)
#define G8_LDA(dst, b, h) do { _Pragma("unroll") for (int m = 0; m < 4; ++m) _Pragma("unroll") for (int k = 0; k < 2; ++k) dst[m][k] = *(const LAS i32x4*)(lds + G8_SA(b, h) + aoff + m * 2048 + k * 1024); } while (0)
#define G8_LDB(dst, b, h) do { _Pragma("unroll") for (int n = 0; n < 2; ++n) _Pragma("unroll") for (int k = 0; k < 2; ++k) dst[n][k] = *(const LAS i32x4*)(lds + G8_SB(b, h) + boff + n * 2048 + k * 1024); } while (0)
#define G8_CAT(v) __builtin_shufflevector(v[0], v[1], 0, 1, 2, 3, 4, 5, 6, 7)
#define G8_MMA(ai, bj, At, Bt) do { __builtin_amdgcn_s_setprio(1); \
        if constexpr (FP8) { _Pragma("unroll") for (int m = 0; m < 4; ++m) _Pragma("unroll") for (int n = 0; n < 2; ++n) { const i32x8 _w = G8_CAT(Bt[n]), _x = G8_CAT(At[m]); \
            asm volatile("s_nop 1\n\tv_mfma_scale_f32_16x16x128_f8f6f4 %0, %1, %2, %0, %3, %4 op_sel_hi:[0,0,0]" : "+v"(acc[ai][bj][m][n]) : "v"(_w), "v"(_x), "v"(sc_w), "v"(sc_a)); } } \
        else { _Pragma("unroll") for (int m = 0; m < 4; ++m) _Pragma("unroll") for (int n = 0; n < 2; ++n) _Pragma("unroll") for (int k = 0; k < 2; ++k) \
            acc[ai][bj][m][n] = __builtin_amdgcn_mfma_f32_16x16x32_bf16((bf16x8)Bt[n][k], (bf16x8)At[m][k], acc[ai][bj][m][n], 0, 0, 0); } \
        __builtin_amdgcn_s_setprio(0); } while (0)
#define G8_WAIT_V(n) asm volatile("s_waitcnt vmcnt(" #n ")" ::: "memory")
#define G8_WAIT_L(n) asm volatile("s_waitcnt lgkmcnt(" #n ")" ::: "memory")
#define G8_BAR __builtin_amdgcn_s_barrier()
#define G8_SCHED __builtin_amdgcn_sched_barrier(0)
    Tile cur, nxt; int ui = 0;
    if (!get_tile(prob, 0, cur)) return;
    Acc acc;
#pragma unroll
    for (int a = 0; a < 2; ++a)
#pragma unroll
        for (int b = 0; b < 2; ++b)
#pragma unroll
            for (int m = 0; m < 4; ++m)
#pragma unroll
                for (int n = 0; n < 2; ++n) acc[a][b][m][n] = (f32x4){0.f, 0.f, 0.f, 0.f};
    i32x4 At[4][2], B0[2][2], B1[2][2];
    const char* cA = cur.a; const char* cB = cur.b;
    if (GAT) { G8_GOFF(goffC, 0); }
    G8_STAGE(G8_SB(0, 0), cB, voffB); G8_STAGE(G8_SB(0, 1), cB + hstepB, voffB); G8_STGA(G8_SA(0, 0), 0, false, cA, 0); G8_STGA(G8_SA(0, 1), 1, false, cA, 0);
    if (wr == 1) G8_BAR;
    G8_WAIT_V(2); G8_BAR;
    G8_STAGE(G8_SB(1, 0), cB + kstep, voffB); G8_STGA(G8_SA(1, 0), 0, false, cA + kstep, 128); G8_STAGE(G8_SB(1, 1), cB + hstepB + kstep, voffB);
    G8_WAIT_V(6); G8_BAR;
    for (;;) {
        const bool has_next = get_tile(prob, ui + 1, nxt);
        const char* nA = has_next ? nxt.a : cA; const char* nB = has_next ? nxt.b : cB;
        if (GAT) { G8_GOFF(goffN, has_next ? ui + 1 : ui); }
        for (int t = 0; t < nt; t += 2) {
            const bool last = (t == nt - 2);
            const char* a1 = cA + (size_t)(t + 1) * kstep;
            const char* a2 = last ? nA : cA + (size_t)(t + 2) * kstep; const char* b2 = last ? nB : cB + (size_t)(t + 2) * kstep;
            const char* a3 = a2 + kstep; const char* b3 = b2 + kstep;
            G8_LDB(B0, 0, 0); G8_LDB(B1, 0, 1); G8_SCHED; G8_LDA(At, 0, 0); G8_STGA(G8_SA(1, 1), 1, false, a1, (t + 1) * 128);
            G8_WAIT_V(8); G8_WAIT_L(0); G8_BAR; G8_MMA(0, 0, At, B0); G8_MMA(0, 1, At, B1); G8_BAR; G8_SCHED;
            G8_LDA(At, 0, 1); G8_STAGE(G8_SB(0, 0), b2, voffB); G8_STAGE(G8_SB(0, 1), b2 + hstepB, voffB); G8_STGA(G8_SA(0, 0), 0, last, a2, last ? 0 : (t + 2) * 128);
            G8_WAIT_V(8); G8_WAIT_L(0); G8_BAR; G8_MMA(1, 0, At, B0); G8_MMA(1, 1, At, B1); G8_BAR; G8_SCHED;
            G8_LDB(B0, 1, 0); G8_LDB(B1, 1, 1); G8_SCHED; G8_LDA(At, 1, 0); G8_STGA(G8_SA(0, 1), 1, last, a2, last ? 0 : (t + 2) * 128);
            G8_WAIT_V(8); G8_WAIT_L(0); G8_BAR; G8_MMA(0, 0, At, B0); G8_MMA(0, 1, At, B1); G8_BAR; G8_SCHED;
            G8_LDA(At, 1, 1); G8_STAGE(G8_SB(1, 0), b3, voffB); G8_STAGE(G8_SB(1, 1), b3 + hstepB, voffB); G8_STGA(G8_SA(1, 0), 0, last, a3, last ? 128 : (t + 3) * 128);
            G8_WAIT_V(8); G8_WAIT_L(0); G8_BAR; G8_MMA(1, 0, At, B0); G8_MMA(1, 1, At, B1); G8_BAR; G8_SCHED;
        }
        if (wr == 0) G8_BAR;
        if (FP8) asm volatile("s_nop 15\n\ts_nop 15" ::: "memory");
        epilogue<FP8>(prob, acc, cur);
        if (!has_next) break;
#pragma unroll
        for (int a = 0; a < 2; ++a)
#pragma unroll
            for (int b = 0; b < 2; ++b)
#pragma unroll
                for (int m = 0; m < 4; ++m)
#pragma unroll
                    for (int n = 0; n < 2; ++n) acc[a][b][m][n] = (f32x4){0.f, 0.f, 0.f, 0.f};
        cur = nxt; cA = nA; cB = nB; ++ui;
        if (GAT) {
#pragma unroll
            for (int _h = 0; _h < 2; ++_h)
#pragma unroll
                for (int _i = 0; _i < 2; ++_i) goffC[_h][_i] = goffN[_h][_i]; }
        if (wr == 1) G8_BAR;
    }
    G8_WAIT_V(0);
    G8_BAR;
#undef G8_SA
#undef G8_SB
#undef G8_STAGE
#undef G8_STGA
#undef G8_GOFF
#undef G8_LDA
#undef G8_LDB
#undef G8_CAT
#undef G8_MMA
#undef G8_WAIT_V
#undef G8_WAIT_L
#undef G8_BAR
#undef G8_SCHED
}
}

struct Args { const float* in[25]; float* out; unsigned char* ws; int ph_lo, ph_hi; };
struct Ctx {
    LAS unsigned char* lds;
    int tid, lane, wave, G, gw, NGW, z;
};
__device__ __forceinline__ int opaque_zero() { int z; asm volatile("s_mov_b32 %0, 0" : "=s"(z)); return z; }
__device__ __forceinline__ Ctx make_ctx(LAS unsigned char* lds) {
    Ctx F; F.lds = lds; F.z = opaque_zero();
    int tz = threadIdx.x; asm volatile("" : "+v"(tz));
    F.tid = tz; F.lane = tz & 63; F.wave = __builtin_amdgcn_readfirstlane(tz >> 6);
    F.G = gridDim.x; { const int bx = blockIdx.x; const int vcu = (F.G % 8 == 0) ? (bx % 8) * (F.G / 8) + bx / 8 : bx; F.gw = vcu * NWAVES + F.wave; }
    F.NGW = F.G * NWAVES;
    return F;
}
#define WSP(T_, off) ((T_*)(args.ws + ((size_t)(off) + (size_t)F.z)))
#define INP(k) (args.in[(k) + F.z])
#define CTXA LAS unsigned char* lds_, const Args& args
#define CTX_LOCAL() const Ctx F = make_ctx(lds_)

__device__ __forceinline__ void tr_item(const float* W, int K, int N, bf16* WT, int drow0, LAS float* scr, int k0, int n0, int lane, const float* ks) {
#pragma unroll 8
    for (int i = 0; i < 32; ++i) { const int kk = 2 * i + (lane >> 5); scr[kk * 33 + (lane & 31)] = __builtin_nontemporal_load(W + (size_t)(k0 + kk) * N + n0 + (lane & 31)) * (ks ? ks[k0 + kk] : 1.f); }
    LDS_WAIT(); asm volatile("" ::: "memory");
    const int c = lane & 7;
#pragma unroll
    for (int j = 0; j < 4; ++j) { const int n = (lane >> 3) + 8 * j; const LAS float* s = scr + (8 * c) * 33 + n;
        u32x4 o; o.x = cvt_pk_bf16(s[0 * 33], s[1 * 33]); o.y = cvt_pk_bf16(s[2 * 33], s[3 * 33]); o.z = cvt_pk_bf16(s[4 * 33], s[5 * 33]); o.w = cvt_pk_bf16(s[6 * 33], s[7 * 33]);
        *(u32x4*)(WT + (size_t)(drow0 + n) * K + k0 + 8 * c) = o; }
    LDS_WAIT(); asm volatile("" ::: "memory");
}

__device__ __forceinline__ void tr_item8(const float* W, int K, int N, unsigned char* WT, int drow0, LAS float* scr, int k0, int n0, int lane, float sc) {
#pragma unroll 8
    for (int i = 0; i < 32; ++i) { const int kk = 2 * i + (lane >> 5); scr[kk * 33 + (lane & 31)] = __builtin_nontemporal_load(W + (size_t)(k0 + kk) * N + n0 + (lane & 31)); }
    LDS_WAIT(); asm volatile("" ::: "memory");
    const int c = lane & 7;
#pragma unroll
    for (int j = 0; j < 4; ++j) { const int n = (lane >> 3) + 8 * j; const LAS float* s = scr + (8 * c) * 33 + n;
        u32x2 o; o.x = pk4_fp8(clamp448(sc * s[0 * 33]), clamp448(sc * s[1 * 33]), clamp448(sc * s[2 * 33]), clamp448(sc * s[3 * 33]));
        o.y = pk4_fp8(clamp448(sc * s[4 * 33]), clamp448(sc * s[5 * 33]), clamp448(sc * s[6 * 33]), clamp448(sc * s[7 * 33]));
        __builtin_nontemporal_store(o, (u32x2*)(WT + (size_t)(drow0 + n) * K + k0 + 8 * c)); }
    LDS_WAIT(); asm volatile("" ::: "memory");
}

__device__ __forceinline__ void p0_prologue(CTXA) {
    CTX_LOCAL();
    LAS float* scr = (LAS float*)(F.lds + F.wave * 16384);
    constexpr int I_EXP = 1024;
    constexpr int N_GU = DEPTH * NE * 2 * I_EXP;
    constexpr int N_DN = DEPTH * NE * I_EXP;
    constexpr int N_WIN = 2 * 1024;
    constexpr int N_SQ = 10 * 512;
    constexpr int N_GT = 32 * 32;
    constexpr int N_PP = 4 * 128;
    constexpr int NITEMS = N_GU + N_DN + N_WIN + N_SQ + N_GT + N_PP;
    for (int it = F.gw; it < NITEMS; it += F.NGW) {
        int r = it; const float* src; bf16* dst; int K, N, k0, n0, drow0; const float* ks = nullptr;
        if (r < N_GU) { const int m = r >> 10, q = r & 1023, which = m & 1, le = m >> 1;
            const int k0e = (q >> 6) * 64, n0e = (q & 63) * 32;
            tr_item8(INP(which ? 21 : 20) + (size_t)le * 1024 * 2048, 1024, 2048, WSP(unsigned char, WS_W1T) + (size_t)le * 4096 * 1024, (n0e >> 7) * 256 + which * 128 + (n0e & 127), scr, k0e, n0e, F.lane, which ? (-512.f * 4.f / L2E) : (-512.f * L2E)); continue; }
        else if ((r -= N_GU) < N_DN) { const int le = r >> 10, q = r & 1023;
            const int k0e = (q >> 5) * 64, n0e = (q & 31) * 32;
            tr_item8(INP(22) + (size_t)le * 2048 * 1024, 2048, 1024, WSP(unsigned char, WS_W2T) + (size_t)le * 1024 * 2048, n0e, scr, k0e, n0e, F.lane, 512.f); continue; }
        else if ((r -= N_DN) < N_WIN) { const int j = r >> 10, q = r & 1023;
            src = INP(6) + (size_t)j * 1024 * 2048; dst = WSP(bf16, WS_WINT) + (size_t)j * 2048 * 1024; K = 1024; N = 2048; ks = INP(2) + (size_t)(2 * j) * D;
            k0 = (q >> 6) * 64; n0 = (q & 63) * 32; drow0 = n0; }
        else if ((r -= N_WIN) < N_SQ) { const int mi = r >> 9, q = r & 511; K = 1024; N = 1024; k0 = (q >> 5) * 64; n0 = (q & 31) * 32; drow0 = n0;
            if (mi < 2) { src = INP(15) + (size_t)mi * 1048576; dst = WSP(bf16, WS_WOUTT) + (size_t)mi * 1048576; }
            else if (mi < 4) { src = INP(17) + (size_t)(mi - 2) * 1048576; dst = WSP(bf16, WS_FTINT) + (size_t)(mi - 2) * 1048576; ks = INP(2) + (size_t)(2 * (mi - 2) + 1) * D; }
            else if (mi < 6) { src = INP(18) + (size_t)(mi - 4) * 1048576; dst = WSP(bf16, WS_FTOUTT) + (size_t)(mi - 4) * 1048576; }
            else { tr_item8(INP(24) + (size_t)(mi - 6) * 1048576, 1024, 1024, WSP(unsigned char, WS_PLEGT) + (size_t)(mi - 6) * 1048576, n0, scr, k0, n0, F.lane, 512.f); continue; } }
        else if ((r -= N_SQ) < N_GT) { const int mi = r >> 5, q = r & 31;
            const int head = mi & 3, d = (mi >> 2) & 1, j = (mi >> 3) & 1, which = mi >> 4;
            src = INP(which ? 12 : 10) + (size_t)((j * 2 + d) * 4 + head) * 65536; dst = WSP(bf16, WS_GATET) + (size_t)(j * 4 + head) * 1024 * 256; K = 256; N = 256;
            k0 = (q >> 3) * 64; n0 = (q & 7) * 32; drow0 = ((d * 2 + (n0 >> 7)) * 2 + which) * 128 + (n0 & 127); }
        else { r -= N_GT; const int li = r >> 7, q = r & 127;
            src = INP(23) + (size_t)li * 256 * 1024; dst = WSP(bf16, WS_PLEPT) + (size_t)li * 1024 * 256; K = 256; N = 1024;
            k0 = (q >> 5) * 64; n0 = (q & 31) * 32; drow0 = n0; }
        tr_item(src, K, N, dst, drow0, scr, k0, n0, F.lane, ks);
    }
    { const float* X = INP(0); bf16* HB = WSP(bf16, WS_HB); float* SSQ = WSP(float, WS_SSQ);
      for (int row0 = F.gw; row0 < T; row0 += 2 * F.NGW) { f32x4 xv[2][4];
#pragma unroll
          for (int rr = 0; rr < 2; ++rr)
#pragma unroll
              for (int j = 0; j < 4; ++j) xv[rr][j] = __builtin_nontemporal_load((const f32x4*)(X + (size_t)(row0 + rr * F.NGW) * D + 4 * F.lane + 256 * j));
          asm volatile("" : "+v"(xv[0][0]), "+v"(xv[0][1]), "+v"(xv[0][2]), "+v"(xv[0][3]), "+v"(xv[1][0]), "+v"(xv[1][1]), "+v"(xv[1][2]), "+v"(xv[1][3]));
#pragma unroll
          for (int rr = 0; rr < 2; ++rr) { const int row = row0 + rr * F.NGW; float ss = 0.f;
#pragma unroll
              for (int j = 0; j < 4; ++j) { const size_t o = (size_t)row * D + 4 * F.lane + 256 * j; const f32x4 v = xv[rr][j];
                  u32x2 w; w.x = cvt_pk_bf16(v[0], v[1]); w.y = cvt_pk_bf16(v[2], v[3]); *(u32x2*)(HB + o) = w; ss += (v[0] * v[0] + v[1] * v[1]) + (v[2] * v[2] + v[3] * v[3]); }
              ss = wave_sum(ss); if (F.lane < 16) SSQ[(size_t)row * 16 + F.lane] = F.lane ? 0.f : ss; } } }
    const size_t gt = (size_t)blockIdx.x * NTHREADS + F.tid, NGT = (size_t)F.G * NTHREADS;
    { const float* p = INP(1); bf16* o = WSP(bf16, WS_PBF);
      for (size_t i0 = gt; i0 < (size_t)DEPTH * T * PLE / 8; i0 += 4 * NGT) { f32x4 pa[4], pb[4];
#pragma unroll
          for (int q = 0; q < 4; ++q) { const size_t i = i0 + q * NGT; const bool ok = i < (size_t)DEPTH * T * PLE / 8; const size_t ii = ok ? i : i0;
              pa[q] = __builtin_nontemporal_load((const f32x4*)(p + ii * 8)); pb[q] = __builtin_nontemporal_load((const f32x4*)(p + ii * 8 + 4)); }
          asm volatile("" : "+v"(pa[0]), "+v"(pa[1]), "+v"(pa[2]), "+v"(pa[3]), "+v"(pb[0]), "+v"(pb[1]), "+v"(pb[2]), "+v"(pb[3]));
#pragma unroll
          for (int q = 0; q < 4; ++q) { const size_t i = i0 + q * NGT; if (i < (size_t)DEPTH * T * PLE / 8) { const f32x4 a = pa[q], b = pb[q];
              u32x4 w; w.x = cvt_pk_bf16(a[0], a[1]); w.y = cvt_pk_bf16(a[2], a[3]); w.z = cvt_pk_bf16(b[0], b[1]); w.w = cvt_pk_bf16(b[2], b[3]); *(u32x4*)(o + i * 8) = w; } } } }
    { bf16* o = WSP(bf16, WS_DFTC);
      for (size_t i = gt; i < 512 * 256 / 8; i += NGT) { const int n = (int)(i >> 5), c0 = (int)(i & 31) * 8, l = n & 255; float v[8];
#pragma unroll
          for (int j = 0; j < 8; ++j) { const int mm = (l * (c0 + j)) & 255; const float x = (float)mm * (1.f / 256.f); v[j] = (n < 256) ? __builtin_amdgcn_cosf(x) : __builtin_amdgcn_sinf(x); }
          u32x4 w; w.x = cvt_pk_bf16(v[0], v[1]); w.y = cvt_pk_bf16(v[2], v[3]); w.z = cvt_pk_bf16(v[4], v[5]); w.w = cvt_pk_bf16(v[6], v[7]); *(u32x4*)(o + i * 8) = w; } }
    { bf16* o = WSP(bf16, WS_DFTS);
      for (size_t i = gt; i < (size_t)4096 * (KH / 8); i += NGT) { const int r = (int)(i / (KH / 8)), c0 = (int)(i % (KH / 8)) * 8, k = r & 2047; float v[8];
#pragma unroll
          for (int j = 0; j < 8; ++j) { const int c = c0 + j; const int mm = (k * (c & 2047)) & 4095; const float x = (float)mm * (1.f / 4096.f);
              v[j] = (c < 2048) ? ((r < 2048) ? __builtin_amdgcn_cosf(x) : __builtin_amdgcn_sinf(x)) * (1.f / 1024.f) : (c == 2048 && r < 2048) ? ((k & 1) ? -1.f / 1024.f : 1.f / 1024.f) : 0.f; }
          u32x4 w; w.x = cvt_pk_bf16(v[0], v[1]); w.y = cvt_pk_bf16(v[2], v[3]); w.z = cvt_pk_bf16(v[4], v[5]); w.w = cvt_pk_bf16(v[6], v[7]); *(u32x4*)(o + i * 8) = w; } }
}

__device__ __forceinline__ void final_pass(CTXA) {
    CTX_LOCAL();
    const bf16* H = WSP(bf16, WS_HB); const float* g = INP(5);
    f32x4 gv[4];
#pragma unroll
    for (int j = 0; j < 4; ++j) gv[j] = *(const f32x4*)(g + 4 * F.lane + 256 * j);
    const int vcu = F.gw / NWAVES, ntrip = ((T / 64 - vcu + F.G - 1) / F.G) * 4;
    for (int tp = 0; tp < ntrip; ++tp) { const int row0 = (vcu + (tp >> 2) * F.G) * 64 + 8 * F.wave + 2 * (tp & 3);
        f32x4 v[2][4];
#pragma unroll
        for (int rr = 0; rr < 2; ++rr)
#pragma unroll
            for (int j = 0; j < 4; ++j) { const u32x2 w = *(const u32x2*)(H + (size_t)(row0 + rr) * D + 4 * F.lane + 256 * j); v[rr][j] = (f32x4){bf_lo(w.x), bf_hi(w.x), bf_lo(w.y), bf_hi(w.y)}; }
#pragma unroll
        for (int rr = 0; rr < 2; ++rr) { float ss = 0.f;
#pragma unroll
            for (int j = 0; j < 4; ++j) ss += (v[rr][j][0] * v[rr][j][0] + v[rr][j][1] * v[rr][j][1]) + (v[rr][j][2] * v[rr][j][2] + v[rr][j][3] * v[rr][j][3]);
            const float rs = rsqrtf(wave_sum(ss) * (1.f / D) + EPS);
#pragma unroll
            for (int j = 0; j < 4; ++j) *(f32x4*)(args.out + (size_t)(row0 + rr) * D + 4 * F.lane + 256 * j) = v[rr][j] * rs * gv[j]; }
    }
}
__device__ __forceinline__ void router_pass(CTXA, int layer) {
    CTX_LOCAL();
    unsigned char* XN8 = WSP(unsigned char, WS_XN); const bf16* H = WSP(bf16, WS_HB); float* AFF = WSP(float, WS_AFF);
    const float* g = INP(3) + layer * D; const float* wr = INP(19) + (size_t)layer * D * NE;
    LAS unsigned char* wt = F.lds;
    LAS float* gl = (LAS float*)(F.lds + 98304);
    LAS float* xb = (LAS float*)(F.lds + 98304 + 4096);
    const int fr = F.lane & 15, fq = F.lane >> 4, half = F.wave & 1, pr = F.wave >> 1;
    const int NT16 = T / 16;
    int base = (F.gw / NWAVES) * 4;
    u32x4 hw[8][2];
#define RT_LOAD(tb) do { const bf16* hp_ = H + (size_t)(((tb) + pr) * 16 + fr) * D + 512 * half + 16 * fq; \
        _Pragma("unroll") for (int j = 0; j < 8; ++j) { hw[j][0] = *(const u32x4*)(hp_ + 64 * j); hw[j][1] = *(const u32x4*)(hp_ + 64 * j + 8); } } while (0)
    { float tmp[32];
#pragma unroll
      for (int q4 = 0; q4 < 4; ++q4) { const int it = F.tid + q4 * NTHREADS, e = it & 15, ch = it >> 4, s = ch >> 2, k0 = 64 * (s >> 1) + 16 * (ch & 3) + 8 * (s & 1);
#pragma unroll
          for (int q = 0; q < 8; ++q) tmp[q4 * 8 + q] = wr[(k0 + q) * NE + e]; }
#pragma unroll
      for (int q4 = 0; q4 < 4; ++q4) { const int it = F.tid + q4 * NTHREADS, ch = it >> 4, s = ch >> 2, k0 = 64 * (s >> 1) + 16 * (ch & 3) + 8 * (s & 1);
          const f32x4 g0 = *(const f32x4*)(g + k0), g1 = *(const f32x4*)(g + k0 + 4);
          float w[8], r1[8], r2[8]; unsigned hi[4], lo[4], l2[4];
#pragma unroll
          for (int q = 0; q < 8; ++q) w[q] = tmp[q4 * 8 + q] * (q < 4 ? g0[q] : g1[q - 4]);
#pragma unroll
          for (int q = 0; q < 4; ++q) { hi[q] = cvt_pk_bf16(w[2 * q], w[2 * q + 1]); r1[2 * q] = w[2 * q] - bf_lo(hi[q]); r1[2 * q + 1] = w[2 * q + 1] - bf_hi(hi[q]); }
#pragma unroll
          for (int q = 0; q < 4; ++q) { lo[q] = cvt_pk_bf16(r1[2 * q], r1[2 * q + 1]); r2[2 * q] = r1[2 * q] - bf_lo(lo[q]); r2[2 * q + 1] = r1[2 * q + 1] - bf_hi(lo[q]); }
#pragma unroll
          for (int q = 0; q < 4; ++q) l2[q] = cvt_pk_bf16(r2[2 * q], r2[2 * q + 1]);
          *(LAS u32x4*)(wt + it * 16) = (u32x4){hi[0], hi[1], hi[2], hi[3]}; *(LAS u32x4*)(wt + 32768 + it * 16) = (u32x4){lo[0], lo[1], lo[2], lo[3]}; *(LAS u32x4*)(wt + 65536 + it * 16) = (u32x4){l2[0], l2[1], l2[2], l2[3]}; }
      gl[F.tid] = g[F.tid]; gl[F.tid + NTHREADS] = g[F.tid + NTHREADS]; }
    __syncthreads();
    while (base < NT16) {
        RT_LOAD(base);
        const int row = (base + pr) * 16 + fr;
        f32x4 a0 = {0.f, 0.f, 0.f, 0.f}, a1 = a0, a2 = a0; float ss = 0.f;
#pragma unroll
        for (int j = 0; j < 8; ++j)
#pragma unroll
            for (int t = 0; t < 2; ++t) { const int s = (8 * half + j) * 2 + t; LAS unsigned char* wp = wt + s * 1024 + F.lane * 16;
                const u32x4 w0 = *(const LAS u32x4*)wp, w1 = *(const LAS u32x4*)(wp + 32768), w2 = *(const LAS u32x4*)(wp + 65536); const u32x4 h = hw[j][t];
                a0 = __builtin_amdgcn_mfma_f32_16x16x32_bf16((bf16x8)w0, (bf16x8)h, a0, 0, 0, 0);
                a1 = __builtin_amdgcn_mfma_f32_16x16x32_bf16((bf16x8)w1, (bf16x8)h, a1, 0, 0, 0);
                a2 = __builtin_amdgcn_mfma_f32_16x16x32_bf16((bf16x8)w2, (bf16x8)h, a2, 0, 0, 0);
                ss += ((bf_lo(h.x) * bf_lo(h.x) + bf_hi(h.x) * bf_hi(h.x)) + (bf_lo(h.y) * bf_lo(h.y) + bf_hi(h.y) * bf_hi(h.y))) + ((bf_lo(h.z) * bf_lo(h.z) + bf_hi(h.z) * bf_hi(h.z)) + (bf_lo(h.w) * bf_lo(h.w) + bf_hi(h.w) * bf_hi(h.w))); }
        ss += __shfl_xor(ss, 16); ss += __shfl_xor(ss, 32);
        f32x4 acc = (a2 + a1) + a0;
        LAS float* xp = xb + pr * 384;
        if (half == 1) { xp[F.lane] = acc[0]; xp[64 + F.lane] = acc[1]; xp[128 + F.lane] = acc[2]; xp[192 + F.lane] = acc[3]; xp[256 + F.lane] = ss; } else xp[320 + F.lane] = ss;
        __syncthreads();
        const float rs = rsqrtf((ss + (half == 1 ? xp[320 + F.lane] : xp[256 + F.lane])) * (1.f / D) + EPS), rs8 = __builtin_ldexpf(rs, 3);
#pragma unroll
        for (int j = 0; j < 8; ++j) { const int k = 512 * half + 64 * j + 16 * fq; u32x4 o;
#pragma unroll
            for (int t = 0; t < 2; ++t) { const f32x4 g0 = *(const LAS f32x4*)(gl + k + 8 * t), g1 = *(const LAS f32x4*)(gl + k + 8 * t + 4); const u32x4 h = hw[j][t];
                const unsigned p0 = pk4_fp8(clamp448(bf_lo(h.x) * g0[0] * rs8), clamp448(bf_hi(h.x) * g0[1] * rs8), clamp448(bf_lo(h.y) * g0[2] * rs8), clamp448(bf_hi(h.y) * g0[3] * rs8));
                const unsigned p1 = pk4_fp8(clamp448(bf_lo(h.z) * g1[0] * rs8), clamp448(bf_hi(h.z) * g1[1] * rs8), clamp448(bf_lo(h.w) * g1[2] * rs8), clamp448(bf_hi(h.w) * g1[3] * rs8));
                if (t == 0) { o.x = p0; o.y = p1; } else { o.z = p0; o.w = p1; } }
            g8::stg16_wt(XN8 + (size_t)row * D + k, o); }
        if (half == 0) {
            f32x4 lg; lg[0] = (acc[0] + xp[F.lane]) * rs; lg[1] = (acc[1] + xp[64 + F.lane]) * rs; lg[2] = (acc[2] + xp[128 + F.lane]) * rs; lg[3] = (acc[3] + xp[192 + F.lane]) * rs;
            float mx = fmaxf(fmaxf(lg[0], lg[1]), fmaxf(lg[2], lg[3])); mx = fmaxf(mx, __shfl_xor(mx, 16)); mx = fmaxf(mx, __shfl_xor(mx, 32));
            f32x4 ex; float sum = 0.f;
#pragma unroll
            for (int j = 0; j < 4; ++j) { ex[j] = __expf(lg[j] - mx); sum += ex[j]; }
            sum += __shfl_xor(sum, 16); sum += __shfl_xor(sum, 32);
            const int b = row >> 12, s = row & 4095;
#pragma unroll
            for (int j = 0; j < 4; ++j) AFF[((size_t)(b * NE + 4 * fq + j)) * S + s] = ex[j] / sum;
        }
        base += F.G * 4;
        __syncthreads();
    }
#undef RT_LOAD
}

__device__ __forceinline__ void conv_pass(CTXA, int j) {
    CTX_LOCAL();
    const bf16* U = WSP(bf16, WS_BUFB); bf16* O = WSP(bf16, WS_BUFC);
    const float* cw = INP(8) + (size_t)j * 4 * D; const float* cb = INP(9) + (size_t)j * D;
    const int vcu = F.gw / NWAVES, rsub = F.tid >> 7;
    const int c0 = (F.tid & 127) * 8;
    float tw[4][8], tb[8];
    { const f32x4 b0 = *(const f32x4*)(cb + c0), b1 = *(const f32x4*)(cb + c0 + 4); tb[0] = b0[0]; tb[1] = b0[1]; tb[2] = b0[2]; tb[3] = b0[3]; tb[4] = b1[0]; tb[5] = b1[1]; tb[6] = b1[2]; tb[7] = b1[3]; }
#pragma unroll
    for (int k = 0; k < 4; ++k) { const f32x4 w0 = *(const f32x4*)(cw + k * D + c0), w1 = *(const f32x4*)(cw + k * D + c0 + 4);
        tw[k][0] = w0[0]; tw[k][1] = w0[1]; tw[k][2] = w0[2]; tw[k][3] = w0[3]; tw[k][4] = w1[0]; tw[k][5] = w1[1]; tw[k][6] = w1[2]; tw[k][7] = w1[3]; }
    for (int tp = 0; tp < ((T / 64 - vcu + F.G - 1) / F.G) * 4; ++tp) {
        const int rbase = (vcu + (tp >> 2) * F.G) * 64 + 16 * (tp & 3) + rsub;
        u32x4 uw[4][4];
#pragma unroll
        for (int q = 0; q < 4; ++q) { const int row = rbase + 4 * q, s = row & 4095;
#pragma unroll
            for (int k = 0; k < 4; ++k) { const int ss = s + k - 2; uw[q][k] = (ss >= 0 && ss < S) ? *(const u32x4*)(U + (size_t)(row + k - 2) * D + c0) : (u32x4){0u, 0u, 0u, 0u}; } }
#pragma unroll
        for (int q = 0; q < 4; ++q) { const int row = rbase + 4 * q;
            float a[8];
#pragma unroll
            for (int e = 0; e < 8; ++e) a[e] = tb[e];
#pragma unroll
            for (int k = 0; k < 4; ++k) { const u32x4 x = uw[q][k];
                a[0] += bf_lo(x.x) * tw[k][0]; a[1] += bf_hi(x.x) * tw[k][1]; a[2] += bf_lo(x.y) * tw[k][2]; a[3] += bf_hi(x.y) * tw[k][3];
                a[4] += bf_lo(x.z) * tw[k][4]; a[5] += bf_hi(x.z) * tw[k][5]; a[6] += bf_lo(x.w) * tw[k][6]; a[7] += bf_hi(x.w) * tw[k][7]; }
            u32x4 w; w.x = cvt_pk_bf16(a[0], a[1]); w.y = cvt_pk_bf16(a[2], a[3]); w.z = cvt_pk_bf16(a[4], a[5]); w.w = cvt_pk_bf16(a[6], a[7]); *(u32x4*)(O + (size_t)row * D + c0) = w; }
    }
}

__device__ __forceinline__ void ft_fold_pass(CTXA) {
    CTX_LOCAL();
    const bf16* U = WSP(bf16, WS_BUFA); bf16* UF = WSP(bf16, WS_BUFB); bf16* PQ = WSP(bf16, WS_LA);
    const size_t gt = (size_t)blockIdx.x * NTHREADS + F.tid, NGT = (size_t)F.G * NTHREADS;
    for (size_t i0 = gt; i0 < (size_t)NB * 2048 * (D / 8); i0 += 4 * NGT) {
        u32x4 xs4[4], ys4[4];
#pragma unroll
        for (int q = 0; q < 4; ++q) { const size_t i = i0 + q * NGT; const int c0 = (int)(i & 127) * 8, s = (int)(i >> 7) & 2047, b = (int)(i >> 18);
            xs4[q] = *(const u32x4*)(U + ((size_t)b * S + s) * D + c0); ys4[q] = *(const u32x4*)(U + ((size_t)b * S + ((S - s) & (S - 1))) * D + c0); }
#pragma unroll
        for (int q = 0; q < 4; ++q) { const size_t i = i0 + q * NGT; const int c0 = (int)(i & 127) * 8, s = (int)(i >> 7) & 2047, b = (int)(i >> 18);
            const u32x4 x = xs4[q], y = ys4[q];
            const unsigned xs[4] = {x.x, x.y, x.z, x.w}, ys[4] = {y.x, y.y, y.z, y.w}; unsigned ps[4], ms[4];
#pragma unroll
            for (int qq = 0; qq < 4; ++qq) { const float a0 = bf_lo(xs[qq]), a1 = bf_hi(xs[qq]), b0 = s ? bf_lo(ys[qq]) : 0.f, b1 = s ? bf_hi(ys[qq]) : 0.f;
                ps[qq] = cvt_pk_bf16(a0 + b0, a1 + b1); ms[qq] = s ? cvt_pk_bf16(a0 - b0, a1 - b1) : 0u; }
            u32x4 wp, wm; wp.x = ps[0]; wp.y = ps[1]; wp.z = ps[2]; wp.w = ps[3]; wm.x = ms[0]; wm.y = ms[1]; wm.z = ms[2]; wm.w = ms[3];
            g8::stg16_wt(UF + (((size_t)b * 2 + 0) * 2048 + s) * D + c0, wp);
            g8::stg16_wt(UF + (((size_t)b * 2 + 1) * 2048 + s) * D + c0, wm); }
    }
    for (int it = F.gw; it < NB * D; it += F.NGW) {
        const int col = it & 1023, b = it >> 10, g = col >> 8, l = col & 255;
        const u32x2 uw = *(const u32x2*)(U + ((size_t)b * S + 2048) * D + g * 256 + 4 * F.lane); const int cq = 4 * F.lane;
        float acc = __builtin_amdgcn_cosf((float)((l * cq) & 255) * (1.f / 256.f)) * bf_lo(uw.x) + __builtin_amdgcn_cosf((float)((l * (cq + 1)) & 255) * (1.f / 256.f)) * bf_hi(uw.x)
                  + __builtin_amdgcn_cosf((float)((l * (cq + 2)) & 255) * (1.f / 256.f)) * bf_lo(uw.y) + __builtin_amdgcn_cosf((float)((l * (cq + 3)) & 255) * (1.f / 256.f)) * bf_hi(uw.y);
        acc = wave_sum(acc);
        bf16* o = PQ + (size_t)it * KSEQ + 2048;
        if (F.lane < 32) { u32x4 w; w.x = (F.lane == 0) ? cvt_pk_bf16(acc, 0.f) : 0u; w.y = 0u; w.z = 0u; w.w = 0u;
            *(u32x4*)(o + (F.lane < 16 ? 8 * F.lane : KH + 8 * (F.lane - 16))) = w; }
    }
}

__device__ __forceinline__ void ft_unfold_pass(CTXA) {
    CTX_LOCAL();
    const bf16* CS = WSP(bf16, WS_Y); bf16* FO = WSP(bf16, WS_BUFC); const bf16* PQ = WSP(bf16, WS_LA);
    const size_t gt = (size_t)blockIdx.x * NTHREADS + F.tid, NGT = (size_t)F.G * NTHREADS;
    for (size_t i0 = gt; i0 < (size_t)NB * 2048 * (D / 8); i0 += 4 * NGT) {
        u32x4 cv[4], sv[4];
#pragma unroll
        for (int q = 0; q < 4; ++q) { const size_t i = i0 + q * NGT; const int c0 = (int)(i & 127) * 8, k = (int)(i >> 7) & 2047, b = (int)(i >> 18);
            cv[q] = *(const u32x4*)(CS + ((size_t)b * S + k) * D + c0); sv[q] = *(const u32x4*)(CS + ((size_t)b * S + 2048 + k) * D + c0); }
#pragma unroll
        for (int q = 0; q < 4; ++q) { const size_t i = i0 + q * NGT; const int c0 = (int)(i & 127) * 8, k = (int)(i >> 7) & 2047, b = (int)(i >> 18);
            const unsigned cs[4] = {cv[q].x, cv[q].y, cv[q].z, cv[q].w}, ss[4] = {sv[q].x, sv[q].y, sv[q].z, sv[q].w}; unsigned lo[4], hi[4];
#pragma unroll
            for (int qq = 0; qq < 4; ++qq) { const float c0f = bf_lo(cs[qq]), c1f = bf_hi(cs[qq]), s0f = bf_lo(ss[qq]), s1f = bf_hi(ss[qq]); lo[qq] = cvt_pk_bf16(c0f - s0f, c1f - s1f); hi[qq] = cvt_pk_bf16(c0f + s0f, c1f + s1f); }
            u32x4 wl, wh; wl.x = lo[0]; wl.y = lo[1]; wl.z = lo[2]; wl.w = lo[3]; wh.x = hi[0]; wh.y = hi[1]; wh.z = hi[2]; wh.w = hi[3];
            g8::stg16_wt(FO + ((size_t)b * S + k) * D + c0, wl);
            if (k) g8::stg16_wt(FO + ((size_t)b * S + (S - k)) * D + c0, wh); }
    }
    for (int it = F.gw; it < NB * D; it += F.NGW) {
        const int col = it & 1023, b = it >> 10; const bf16* pr = PQ + (size_t)it * KSEQ; float a = 0.f; u32x4 pw[4];
#pragma unroll
        for (int q = 0; q < 4; ++q) pw[q] = *(const u32x4*)(pr + (q * 64 + F.lane) * 8);
        unsigned p2k = (unsigned)pr[2048];
        asm volatile("" : "+v"(pw[0]), "+v"(pw[1]), "+v"(pw[2]), "+v"(pw[3]), "+v"(p2k));
#pragma unroll
        for (int q = 0; q < 4; ++q) { const u32x4 w = pw[q];
            a += (bf_lo(w.x) - bf_hi(w.x)) + (bf_lo(w.y) - bf_hi(w.y)) + (bf_lo(w.z) - bf_hi(w.z)) + (bf_lo(w.w) - bf_hi(w.w)); }
        a = wave_sum(a);
        if (F.lane == 0) { const float p2048 = __uint_as_float(p2k << 16); FO[((size_t)b * S + 2048) * D + col] = (bf16)(cvt_pk_bf16((a + p2048) * (1.f / 1024.f), 0.f) & 0xffffu); }
    }
}

__device__ __forceinline__ void scan_s1(CTXA) {
    CTX_LOCAL();
    const bf16* LA = WSP(bf16, WS_LA); const bf16* BB = WSP(bf16, WS_BB); float* CA = WSP(float, WS_CA); float* CB = WSP(float, WS_CB);
    for (int it = F.gw; it < 2 * NB * 64 * 8; it += F.NGW) {
        const int cg = it & 7, chunk = (it >> 3) & 63, b = (it >> 9) & 3, d = it >> 11;
        const int ch = cg * 128 + 2 * F.lane;
        const size_t e0 = (size_t)d * T * D + ((size_t)b * S + chunk * 64) * D + ch;
        const unsigned* la = (const unsigned*)(LA + e0); const unsigned* bb = (const unsigned*)(BB + e0);
        float A0 = 0.f, A1 = 0.f, B0 = 0.f, B1 = 0.f;
#pragma unroll
        for (int g = 0; g < 4; ++g) { unsigned wl[16], wb[16];
#pragma unroll
            for (int q = 0; q < 16; ++q) { const int tt = g * 16 + q, t = d ? 63 - tt : tt; wl[q] = la[(size_t)t * (D / 2)]; wb[q] = bb[(size_t)t * (D / 2)]; }
#pragma unroll
            for (int q = 0; q < 16; ++q) { const float l0 = bf_lo(wl[q]), l1 = bf_hi(wl[q]);
                A0 += l0; A1 += l1; B0 = __expf(l0) * B0 + bf_lo(wb[q]); B1 = __expf(l1) * B1 + bf_hi(wb[q]); } }
        const size_t o = ((size_t)((d * NB + b) * 64 + chunk)) * D + ch;
        *(f32x2*)(CA + o) = (f32x2){A0, A1}; *(f32x2*)(CB + o) = (f32x2){B0, B1};
    }
}
__device__ __forceinline__ void scan_s3(CTXA) {
    CTX_LOCAL();
    const bf16* LA = WSP(bf16, WS_LA); const bf16* BB = WSP(bf16, WS_BB); const float* CA = WSP(float, WS_CA); const float* CB = WSP(float, WS_CB);
    const bf16* GG = WSP(bf16, WS_BUFA); bf16* Y = WSP(bf16, WS_Y);
    for (int it = F.gw; it < NB * 64 * 8; it += F.NGW) {
        const int cg = it & 7, chunk = (it >> 3) & 63, b = it >> 9;
        const int ch = cg * 128 + 2 * F.lane;
        float hf0 = 0.f, hf1 = 0.f, hb0 = 0.f, hb1 = 0.f;
        for (int c0 = 0; c0 < chunk; c0 += 16) { f32x2 av[16], bv[16];
#pragma unroll
            for (int q = 0; q < 16; ++q) { const int c = c0 + q; const bool ok = c < chunk; const size_t o = ((size_t)((0 * NB + b) * 64 + (ok ? c : 0))) * D + ch;
                av[q] = *(const f32x2*)(CA + o); bv[q] = *(const f32x2*)(CB + o); if (!ok) { av[q] = (f32x2){0.f, 0.f}; bv[q] = (f32x2){0.f, 0.f}; } }
#pragma unroll
            for (int q = 0; q < 16; ++q) { hf0 = __expf(av[q].x) * hf0 + bv[q].x; hf1 = __expf(av[q].y) * hf1 + bv[q].y; } }
        for (int c0 = 63; c0 > chunk; c0 -= 16) { f32x2 av[16], bv[16];
#pragma unroll
            for (int q = 0; q < 16; ++q) { const int c = c0 - q; const bool ok = c > chunk; const size_t o = ((size_t)((1 * NB + b) * 64 + (ok ? c : 63))) * D + ch;
                av[q] = *(const f32x2*)(CA + o); bv[q] = *(const f32x2*)(CB + o); if (!ok) { av[q] = (f32x2){0.f, 0.f}; bv[q] = (f32x2){0.f, 0.f}; } }
#pragma unroll
            for (int q = 0; q < 16; ++q) { hb0 = __expf(av[q].x) * hb0 + bv[q].x; hb1 = __expf(av[q].y) * hb1 + bv[q].y; } }
        const size_t e0 = ((size_t)b * S + chunk * 64) * D + ch;
        const unsigned* la0 = (const unsigned*)(LA + e0); const unsigned* bb0 = (const unsigned*)(BB + e0);
        const unsigned* la1 = (const unsigned*)(LA + (size_t)T * D + e0); const unsigned* bb1 = (const unsigned*)(BB + (size_t)T * D + e0);
        const unsigned* gg = (const unsigned*)(GG + e0); unsigned* yy = (unsigned*)(Y + e0);
        float fv0[64], fv1[64];
#pragma unroll
        for (int g = 0; g < 4; ++g) { unsigned wl[16], wb[16];
#pragma unroll
            for (int q = 0; q < 16; ++q) { const int t = g * 16 + q; wl[q] = la0[(size_t)t * (D / 2)]; wb[q] = bb0[(size_t)t * (D / 2)]; }
#pragma unroll
            for (int q = 0; q < 16; ++q) { const int t = g * 16 + q; hf0 = __expf(bf_lo(wl[q])) * hf0 + bf_lo(wb[q]); hf1 = __expf(bf_hi(wl[q])) * hf1 + bf_hi(wb[q]); fv0[t] = hf0; fv1[t] = hf1; } }
#pragma unroll
        for (int g = 0; g < 4; ++g) { unsigned wl[16], wb[16], wg[16];
#pragma unroll
            for (int q = 0; q < 16; ++q) { const int t = 63 - (g * 16 + q); wl[q] = la1[(size_t)t * (D / 2)]; wb[q] = bb1[(size_t)t * (D / 2)]; wg[q] = gg[(size_t)t * (D / 2)]; }
#pragma unroll
            for (int q = 0; q < 16; ++q) { const int t = 63 - (g * 16 + q); hb0 = __expf(bf_lo(wl[q])) * hb0 + bf_lo(wb[q]); hb1 = __expf(bf_hi(wl[q])) * hb1 + bf_hi(wb[q]);
                yy[(size_t)t * (D / 2)] = cvt_pk_bf16((fv0[t] + hb0) * bf_lo(wg[q]), (fv1[t] + hb1) * bf_hi(wg[q])); } }
    }
}

__device__ __forceinline__ void topk_pass(CTXA) {
    CTX_LOCAL();
    const float* AFF = WSP(float, WS_AFF); float* GATEV = WSP(float, WS_GATEV); int* SLOTOF = WSP(int, WS_SLOTOF);
    LAS unsigned* wcnt = (LAS unsigned*)F.lds;
    LAS unsigned* wtot = (LAS unsigned*)(F.lds + 256);
    int* IDX = WSP(int, WS_IDX);
    for (int pair = blockIdx.x; pair < NB * NE; pair += F.G) {
        const int b = pair >> 4, e = pair & 15;
        const float* aff = AFF + (size_t)pair * S + 8 * F.tid;
        const f32x4 v0 = *(const f32x4*)aff, v1 = *(const f32x4*)(aff + 4);
        float val[8] = {v0[0], v0[1], v0[2], v0[3], v1[0], v1[1], v1[2], v1[3]};
        unsigned key[8];
#pragma unroll
        for (int i = 0; i < 8; ++i) key[i] = __float_as_uint(val[i]);
        unsigned Tk = 0u; int par = 0;
        for (int bit = 30; bit >= 0; --bit) {
            const unsigned cand = Tk | (1u << bit); unsigned c = 0;
#pragma unroll
            for (int i = 0; i < 8; ++i) c += (unsigned)__builtin_popcountll(__ballot(key[i] >= cand));
            if (F.lane == 0) wcnt[par * 8 + F.wave] = c;
            __syncthreads();
            unsigned tot = 0;
#pragma unroll
            for (int w = 0; w < 8; ++w) tot += wcnt[par * 8 + w];
            if (tot >= (unsigned)CAP) Tk = cand;
            par ^= 1;
        }
        int gtc = 0, eqc = 0;
#pragma unroll
        for (int i = 0; i < 8; ++i) { gtc += key[i] > Tk; eqc += key[i] == Tk; }
        int gin = gtc, ein = eqc;
#pragma unroll
        for (int o = 1; o < 64; o <<= 1) { const int g2 = __shfl_up(gin, o), e2 = __shfl_up(ein, o); if (F.lane >= o) { gin += g2; ein += e2; } }
        if (F.lane == 63) { wtot[F.wave] = (unsigned)gin; wtot[8 + F.wave] = (unsigned)ein; }
        __syncthreads();
        int gb = gin - gtc, eb = ein - eqc, ngt = 0;
#pragma unroll
        for (int w = 0; w < 8; ++w) { const int g2 = (int)wtot[w], e2 = (int)wtot[8 + w]; ngt += g2; if (w < F.wave) { gb += g2; eb += e2; } }
        const int need_eq = CAP - ngt, slot0 = (e * NB + b) * CAP;
        int so[8];
#pragma unroll
        for (int i = 0; i < 8; ++i) { const bool g = key[i] > Tk, q = key[i] == Tk; const bool sel = g || (q && eb < need_eq); const int pos = gb + (eb < need_eq ? eb : need_eq);
            if (sel) { IDX[slot0 + pos] = 8 * F.tid + i; GATEV[slot0 + pos] = val[i]; }
            so[i] = sel ? pos : -1; gb += g; eb += q; }
        int* sp = SLOTOF + (size_t)pair * S + 8 * F.tid;
        *(int4*)sp = make_int4(so[0], so[1], so[2], so[3]); *(int4*)(sp + 4) = make_int4(so[4], so[5], so[6], so[7]);
        __syncthreads();
        __syncthreads();
    }
}


__device__ __forceinline__ void combine_pass(CTXA, int layer) {
    CTX_LOCAL();
    bf16* H = WSP(bf16, WS_HB); unsigned char* XN8 = WSP(unsigned char, WS_XN); const unsigned char* YG = WSP(unsigned char, WS_YG); const int* SLOTOF = WSP(int, WS_SLOTOF);
    const float* g = INP(4) + layer * D;
    f32x4 gv[4];
#pragma unroll
    for (int j = 0; j < 4; ++j) gv[j] = *(const f32x4*)(g + 4 * F.lane + 256 * j);
    const int vcu = F.gw / NWAVES, ntrip = ((T / 64 - vcu + F.G - 1) / F.G) * 4;
#define CMB_ROW(tp, rr) ((vcu + ((tp) >> 2) * F.G) * 64 + 8 * F.wave + 2 * ((tp) & 3) + (rr))
    int sln[2];
#pragma unroll
    for (int rr = 0; rr < 2; ++rr) { const int row = CMB_ROW(0, rr); sln[rr] = (ntrip > 0) ? SLOTOF[((size_t)((row >> 12) * NE + (F.lane & 15))) * S + (row & 4095)] : -1; }
    for (int tp = 0; tp < ntrip; ++tp) {
        int sl[2]; f32x4 v[2][4]; unsigned em[2]; unsigned yw[2][4][4]; float wgt[2][4];
#pragma unroll
        for (int rr = 0; rr < 2; ++rr) { const int row = CMB_ROW(tp, rr);
            sl[rr] = sln[rr]; { const int rown = CMB_ROW(tp + 1, rr); sln[rr] = (tp + 1 < ntrip) ? SLOTOF[((size_t)((rown >> 12) * NE + (F.lane & 15))) * S + (rown & 4095)] : -1; }
#pragma unroll
            for (int j = 0; j < 4; ++j) { const u32x2 w = *(const u32x2*)(H + (size_t)row * D + 4 * F.lane + 256 * j); v[rr][j] = (f32x4){bf_lo(w.x), bf_hi(w.x), bf_lo(w.y), bf_hi(w.y)}; } }
#pragma unroll
        for (int rr = 0; rr < 2; ++rr) { const int row = CMB_ROW(tp, rr), b = row >> 12;
            em[rr] = (unsigned)(__ballot(sl[rr] >= 0) & 0xFFFFull);
#pragma unroll
            for (int q = 0; q < 4; ++q) { const bool valid = em[rr] != 0u; const int e = valid ? __builtin_ctz(em[rr]) : 0; em[rr] &= em[rr] - 1u;
                const int se = __builtin_amdgcn_readlane(sl[rr], e); wgt[rr][q] = __builtin_ldexpf(valid ? 1.f : 0.f, -6);
                const unsigned char* y = YG + ((size_t)((e * NB + b) * CAP + (valid ? se : 0))) * D + 4 * F.lane;
#pragma unroll
                for (int j = 0; j < 4; ++j) yw[rr][q][j] = *(const unsigned*)(y + 256 * j); } }
#pragma unroll
        for (int rr = 0; rr < 2; ++rr) { const int row = CMB_ROW(tp, rr), b = row >> 12;
#pragma unroll
            for (int q = 0; q < 4; ++q)
#pragma unroll
                for (int j = 0; j < 4; ++j) { const int w = (int)yw[rr][q][j]; const float g1 = wgt[rr][q];
                    v[rr][j][0] += g1 * __builtin_amdgcn_cvt_f32_fp8(w, 0); v[rr][j][1] += g1 * __builtin_amdgcn_cvt_f32_fp8(w, 1); v[rr][j][2] += g1 * __builtin_amdgcn_cvt_f32_fp8(w, 2); v[rr][j][3] += g1 * __builtin_amdgcn_cvt_f32_fp8(w, 3); }
            unsigned m2 = em[rr];
            while (m2) { const int e = __builtin_ctz(m2); m2 &= m2 - 1u; const int se = __builtin_amdgcn_readlane(sl[rr], e);
                const unsigned char* y = YG + ((size_t)((e * NB + b) * CAP + se)) * D + 4 * F.lane;
#pragma unroll
                for (int j = 0; j < 4; ++j) { const int w = (int)*(const unsigned*)(y + 256 * j); const float g1 = 1.f / 64.f;
                    v[rr][j][0] += g1 * __builtin_amdgcn_cvt_f32_fp8(w, 0); v[rr][j][1] += g1 * __builtin_amdgcn_cvt_f32_fp8(w, 1); v[rr][j][2] += g1 * __builtin_amdgcn_cvt_f32_fp8(w, 2); v[rr][j][3] += g1 * __builtin_amdgcn_cvt_f32_fp8(w, 3); } }
            float ss = 0.f;
#pragma unroll
            for (int j = 0; j < 4; ++j) { u32x2 hw2; hw2.x = cvt_pk_bf16(v[rr][j][0], v[rr][j][1]); hw2.y = cvt_pk_bf16(v[rr][j][2], v[rr][j][3]); *(u32x2*)(H + (size_t)row * D + 4 * F.lane + 256 * j) = hw2; ss += (v[rr][j][0] * v[rr][j][0] + v[rr][j][1] * v[rr][j][1]) + (v[rr][j][2] * v[rr][j][2] + v[rr][j][3] * v[rr][j][3]); }
            const float rs = rsqrtf(wave_sum(ss) * (1.f / D) + EPS);
#pragma unroll
            for (int j = 0; j < 4; ++j) { const f32x4 o = v[rr][j] * rs * gv[j]; *(unsigned*)(XN8 + (size_t)row * D + 4 * F.lane + 256 * j) = pk4_fp8(clamp448(8.f * o[0]), clamp448(8.f * o[1]), clamp448(8.f * o[2]), clamp448(8.f * o[3])); } }
    }
#undef CMB_ROW
}

constexpr int PH_PER_LAYER = 16, PH_FINAL = 1 + DEPTH * PH_PER_LAYER, PH_END = PH_FINAL + 1;
__host__ __device__ inline bool phase_exists(int ph) {
    if (ph == 0 || ph == PH_FINAL) return true;
    if (ph < 0 || ph > PH_FINAL) return false;
    const int l = (ph - 1) / PH_PER_LAYER, k = (ph - 1) % PH_PER_LAYER;
    if (k >= 15 || k == 0) return false;
    if (k == 8) return false;
    if (k == 10) return false;

    return true;
}

__global__ void __launch_bounds__(NTHREADS, 2) mk_fwd(Args args) {
    extern __shared__ __attribute__((aligned(16))) unsigned char lds_raw[];
    LAS unsigned char* const lds = (LAS unsigned char*)lds_raw;
    volatile LAS unsigned* MISC = (volatile LAS unsigned*)(lds + MISC_OFF);
    for (int u = threadIdx.x; u < 256; u += NTHREADS) MISC[u] = 0u;
    __syncthreads();
    const int lo = args.ph_lo, hi = args.ph_hi;
    const bool multi = (hi - lo) > 1;
    const bool grp_ok = multi && gridDim.x == 256u; const int grp_id = (int)(((blockIdx.x & 7u) * 32u + (blockIdx.x >> 3)) >> 2); unsigned grp_uses = 0u;
    if (grp_ok && threadIdx.x == 0) __hip_atomic_store((unsigned*)(args.ws + WS_CTL) + CW_XID + ((blockIdx.x & 7u) * 32u + (blockIdx.x >> 3)), xb_xcc_id() + 1u, __ATOMIC_RELAXED, __HIP_MEMORY_SCOPE_AGENT);
    XcdBarrier bar; bar.bar = (unsigned*)(args.ws + WS_CTL) + CW_BAR; bar.x = 0; bar.st = MISC + 8;
    if (multi) bar = xcd_barrier_post((unsigned*)(args.ws + WS_CTL) + CW_BAR, MISC + 8);

#ifndef PROBE_REPEAT
#define PROBE_REPEAT(ph) 0
#endif
    for (int ph0 = lo, rep = 0; ph0 < hi; ) {
        const int ph = ph0;
        if (rep < PROBE_REPEAT(ph)) ++rep; else { rep = 0; ++ph0; }
        if (!phase_exists(ph)) continue;
        struct { int z; } F; F.z = opaque_zero();
        bool isg = false; g8::Desc gd;
        gd.kind = g8::K_PLAIN; gd.K = D; gd.lda = D; gd.ldb = D; gd.nM = 64; gd.nN = 4; gd.ldo = D; gd.esz = 2; gd.gidx = nullptr; gd.u0 = (int)blockIdx.x; gd.ustride = (int)gridDim.x; gd.grp = 0; gd.sc_w = 0x7F7F7F7F; gd.sc_a = 0x7F7F7F7F; gd.A = nullptr; gd.Bt = nullptr; gd.o0 = nullptr; gd.o1 = nullptr; gd.p0 = nullptr; gd.p1 = nullptr; gd.p2 = nullptr;
        if (ph == 0) p0_prologue(lds, args);
        else if (ph == PH_FINAL) final_pass(lds, args);
        else {
            const int layer = (ph - 1) / PH_PER_LAYER, k = (ph - 1) % PH_PER_LAYER, j = layer >> 1; const bool rg = (layer & 1) == 0;
            switch (k) {
            case 1: isg = true; gd.A = WSP(bf16, WS_HB); gd.grp = grp_ok ? 1 : 0;
                if (rg) { gd.kind = g8::K_RGIN; gd.nN = 8; gd.Bt = WSP(bf16, WS_WINT) + (size_t)j * 2048 * 1024; gd.p0 = INP(7) + (size_t)j * 2048; gd.p1 = WSP(float, WS_SSQ); gd.o0 = WSP(bf16, WS_BUFA); gd.o1 = WSP(bf16, WS_BUFB); }
                else { gd.Bt = WSP(bf16, WS_FTINT) + (size_t)j * 1048576; gd.p0 = WSP(float, WS_SSQ); gd.o0 = WSP(bf16, WS_BUFA); }
                break;
            case 2: if (rg) conv_pass(lds, args, j); else ft_fold_pass(lds, args); break;
            case 3: isg = true;
                if (rg) { gd.kind = g8::K_RGGATE; gd.grp = grp_ok ? 1 : 0; gd.K = 256; gd.lda = D; gd.ldb = 256; gd.nN = 16; gd.A = WSP(bf16, WS_BUFC); gd.Bt = WSP(bf16, WS_GATET) + (size_t)j * 4 * 1024 * 256;
                    gd.p0 = INP(11) + (size_t)j * 2048; gd.p1 = INP(13) + (size_t)j * 2048; gd.p2 = INP(14) + (size_t)j * 2048; gd.o0 = WSP(bf16, WS_LA); gd.o1 = WSP(bf16, WS_BB); }
                else { gd.kind = g8::K_FTCH; gd.K = 256; gd.lda = 256; gd.ldb = D; gd.nM = 32; gd.nN = 8; gd.ldo = KSEQ; gd.A = WSP(bf16, WS_DFTC); gd.Bt = WSP(bf16, WS_BUFB); gd.o0 = WSP(bf16, WS_LA); }
                break;
            case 4: if (rg) scan_s1(lds, args);
                else { isg = true; gd.kind = g8::K_FTSEQ; gd.K = KH; gd.lda = KH; gd.ldb = KSEQ; gd.A = WSP(bf16, WS_DFTS); gd.Bt = WSP(bf16, WS_LA); gd.o0 = WSP(bf16, WS_Y); }
                break;
            case 5: if (rg) scan_s3(lds, args); else ft_unfold_pass(lds, args); break;
            case 6: isg = true; gd.kind = g8::K_RESID; gd.o0 = WSP(bf16, WS_HB); gd.grp = grp_ok ? 1 : 0;
                if (rg) { gd.A = WSP(bf16, WS_Y); gd.Bt = WSP(bf16, WS_WOUTT) + (size_t)j * 1048576; gd.p0 = INP(16) + (size_t)j * D; }
                else { gd.A = WSP(bf16, WS_BUFC); gd.Bt = WSP(bf16, WS_FTOUTT) + (size_t)j * 1048576; }
                break;
            case 7: router_pass(lds, args, layer); break;
            case 9: topk_pass(lds, args);
                isg = true; gd.K = PLE; gd.lda = PLE; gd.ldb = PLE; gd.A = WSP(bf16, WS_PBF) + (size_t)layer * T * PLE; gd.Bt = WSP(bf16, WS_PLEPT) + (size_t)layer * 1024 * 256; gd.o0 = WSP(bf16, WS_PP) + (size_t)layer * T * D;
                { const int npair = NB * NE, G = (int)gridDim.x;
                  if (G == 256) { const int bx = (int)blockIdx.x; gd.ustride = 1 << 20; gd.u0 = (bx >= npair) ? bx - npair : (G - npair) + bx; }
                  else if (G > npair) { gd.u0 = (int)blockIdx.x - npair; gd.ustride = G - npair; } }
                break;
            case 11: isg = true; gd.kind = g8::K_FFN1; gd.grp = grp_ok ? 1 : 0; gd.nM = 128; gd.nN = 16; gd.esz = 1; gd.sc_w = 0x76767676; gd.sc_a = 0x7C7C7C7C;
                gd.A = WSP(unsigned char, WS_XN); gd.gidx = WSP(int, WS_IDX); gd.Bt = WSP(unsigned char, WS_W1T) + (size_t)layer * NE * 4096 * 1024; gd.o0 = WSP(unsigned char, WS_HG); break;
            case 12: isg = true; gd.kind = g8::K_FFN2; gd.grp = grp_ok ? 1 : 0; gd.K = FF; gd.lda = FF; gd.ldb = FF; gd.nM = 128; gd.esz = 1; gd.sc_w = 0x76767676; gd.sc_a = 0x7D7D7D7D;
                gd.A = WSP(unsigned char, WS_HG); gd.Bt = WSP(unsigned char, WS_W2T) + (size_t)layer * NE * 1024 * 2048; gd.p0 = WSP(float, WS_GATEV); gd.o0 = WSP(unsigned char, WS_YG); break;
            case 13: combine_pass(lds, args, layer); break;
            case 14: isg = true; gd.kind = g8::K_PLE; gd.esz = 1; gd.grp = grp_ok ? 1 : 0; gd.sc_w = 0x76767676; gd.sc_a = 0x7C7C7C7C; gd.A = WSP(unsigned char, WS_XN); gd.Bt = WSP(unsigned char, WS_PLEGT) + (size_t)layer * 1048576; gd.p0 = WSP(bf16, WS_PP) + (size_t)layer * T * D; gd.p1 = WSP(float, WS_SSQ); gd.o0 = WSP(bf16, WS_HB); break;
            default: break;
            }
        }
        if (isg) { if (gd.esz == 1) g8::gemm_phase<true>(lds, gd); else g8::gemm_phase<false>(lds, gd); }
        if (multi && ph0 < hi) {
            const int kk = (ph >= 1 && ph < PH_FINAL) ? (ph - 1) % PH_PER_LAYER : -1;
            const bool rgl = (((ph - 1) / PH_PER_LAYER) & 1) == 0;
            if (grp_ok && (kk == 6 || kk == 11 || kk == 13 || kk == 14 || (rgl && (kk == 2 || kk == 3 || kk == 5)))) group_barrier((unsigned*)(args.ws + WS_CTL), grp_id, 4u * (++grp_uses), MISC + 12);
            else xcd_barrier(bar);
        }
    }
}

extern "C" void kernel_launch(void* const* d_in, const int* in_sizes, int n_in, void* d_out, int out_size, void* d_ws, size_t ws_size, hipStream_t stream) {
    static int grid = 0;
    if (grid == 0) {
        if (n_in != 25 || in_sizes[0] != T * D || out_size != T * D || ws_size < WS_END) {
            fprintf(stderr, "kernel_launch: unexpected shapes (n_in %d, in0 %d, out %d, ws %zu < %zu); nothing launched\n", n_in, n_in > 0 ? in_sizes[0] : -1, out_size, ws_size, (size_t)WS_END); grid = -1; return; }
        int dev = 0, cus = 0, per_cu = 0;
        if (hipGetDevice(&dev) != hipSuccess || hipDeviceGetAttribute(&cus, hipDeviceAttributeMultiprocessorCount, dev) != hipSuccess) { grid = -1; return; }
        if (hipFuncSetAttribute((const void*)mk_fwd, hipFuncAttributeMaxDynamicSharedMemorySize, LDS_BYTES) != hipSuccess) { fprintf(stderr, "kernel_launch: hipFuncSetAttribute failed\n"); grid = -1; return; }
        if (hipOccupancyMaxActiveBlocksPerMultiprocessor(&per_cu, (const void*)mk_fwd, NTHREADS, LDS_BYTES) != hipSuccess || per_cu < 1)
            fprintf(stderr, "kernel_launch: occupancy query reports %d workgroups per CU\n", per_cu);
        (void)hipGetLastError();
        grid = cus;
    }
    if (grid < 0) return;
    (void)hipMemsetAsync((char*)d_ws + WS_CTL, 0, CTL_ZERO_BYTES, stream);
    Args a{};
    for (int i = 0; i < 25; ++i) a.in[i] = (const float*)d_in[i];
    a.out = (float*)d_out; a.ws = (unsigned char*)d_ws;
#if MK_ONE_LAUNCH
    a.ph_lo = 0; a.ph_hi = PH_END;
    hipLaunchKernelGGL(mk_fwd, dim3(grid), dim3(NTHREADS), LDS_BYTES, stream, a);
#else
    for (int ph = 0; ph < PH_END; ++ph) {
        if (!phase_exists(ph)) continue;
        a.ph_lo = ph; a.ph_hi = ph + 1;
        hipLaunchKernelGGL(mk_fwd, dim3(grid), dim3(NTHREADS), LDS_BYTES, stream, a);
    }
#endif
}
```

```cpp
#include <hip/hip_runtime.h>
#include <cstdio>
#include <cstdint>

#ifndef MK_ONE_LAUNCH
#define MK_ONE_LAUNCH 1
#endif

#define LAS __attribute__((address_space(3)))
typedef unsigned short bf16;
typedef short bf16x8 __attribute__((ext_vector_type(8)));
typedef float f32x4 __attribute__((ext_vector_type(4)));
typedef float f32x2 __attribute__((ext_vector_type(2)));
typedef unsigned u32x2 __attribute__((ext_vector_type(2)));
typedef unsigned u32x4 __attribute__((ext_vector_type(4)));

constexpr int NB = 4, S = 4096, D = 1024, T = NB * S, DEPTH = 4, NE = 16, CAP = 512, FF = 2048, PLE = 256, NSLOT = NE * NB * CAP;
constexpr float EPS = 1e-6f;
constexpr int KQ = 1152;
constexpr int KSEQ = 4 * KQ;
constexpr int NWAVES = 8, NTHREADS = 512;

constexpr size_t MiB = 1u << 20;
constexpr size_t WS_CTL = 0, CTL_ZERO_BYTES = 1 * MiB;
constexpr size_t WS_W1T = 1 * MiB;
constexpr size_t WS_W2T = WS_W1T + 256 * MiB;
constexpr size_t WS_WINT = WS_W2T + 128 * MiB;
constexpr size_t WS_GATET = WS_WINT + 8 * MiB;
constexpr size_t WS_WOUTT = WS_GATET + 4 * MiB;
constexpr size_t WS_FTINT = WS_WOUTT + 4 * MiB;
constexpr size_t WS_FTOUTT = WS_FTINT + 4 * MiB;
constexpr size_t WS_PLEGT = WS_FTOUTT + 4 * MiB;
constexpr size_t WS_PLEPT = WS_PLEGT + 8 * MiB;
constexpr size_t WS_DFTC = WS_PLEPT + 2 * MiB;
constexpr size_t WS_DFTS = WS_DFTC + 1 * MiB;
constexpr size_t WS_PBF = WS_DFTS + 64 * MiB;
constexpr size_t WS_H = WS_PBF + 32 * MiB;
constexpr size_t WS_XN = WS_H + 64 * MiB;
constexpr size_t WS_BUFA = WS_XN + 32 * MiB;
constexpr size_t WS_BUFB = WS_BUFA + 32 * MiB;
constexpr size_t WS_BUFC = WS_BUFB + 32 * MiB;
constexpr size_t WS_LA = WS_BUFC + 32 * MiB;
constexpr size_t WS_BB = WS_LA + 64 * MiB;
constexpr size_t WS_Y = WS_BB + 64 * MiB;
constexpr size_t WS_CA = WS_Y + 32 * MiB;
constexpr size_t WS_CB = WS_CA + 2 * MiB;
constexpr size_t WS_AFF = WS_CB + 2 * MiB;
constexpr size_t WS_IDX = WS_AFF + 1 * MiB;
constexpr size_t WS_GATEV = WS_IDX + 1 * MiB;
constexpr size_t WS_SLOTOF = WS_GATEV + 1 * MiB;
constexpr size_t WS_XG = WS_SLOTOF + 1 * MiB;
constexpr size_t WS_HG = WS_XG + 64 * MiB;
constexpr size_t WS_YG = WS_HG + 128 * MiB;
constexpr size_t WS_PP = WS_YG + 64 * MiB;
constexpr size_t WS_HB = WS_PP + 128 * MiB;
constexpr size_t WS_SSQ = WS_HB + 32 * MiB;
constexpr size_t WS_END = WS_SSQ + 1 * MiB;

constexpr int CW_BAR = 4096;

constexpr int RING_BYTES = 131072;
constexpr int MISC_OFF = RING_BYTES;
constexpr int LDS_BYTES = 147456;

__device__ __forceinline__ unsigned cvt_pk_bf16(float lo, float hi) { unsigned r; asm("v_cvt_pk_bf16_f32 %0, %1, %2" : "=v"(r) : "v"(lo), "v"(hi)); return r; }
__device__ __forceinline__ float bf_lo(unsigned w) { return __uint_as_float(w << 16); }
__device__ __forceinline__ float bf_hi(unsigned w) { return __uint_as_float(w & 0xffff0000u); }
__device__ __forceinline__ float wave_sum(float v) {
#pragma unroll
    for (int o = 1; o < 64; o <<= 1) v += __shfl_xor(v, o);
    return v;
}
__device__ __forceinline__ float sigmoidf_(float x) { return __builtin_amdgcn_rcpf(1.f + __expf(-x)); }
constexpr float L2E = 1.4426950408889634f;
__device__ __forceinline__ float gelu_tanh(float x) {
    const float C0 = 2.f * 0.7978845608028654f * L2E, C1 = 2.f * 0.7978845608028654f * 0.044715f * L2E;
    const float e = __builtin_amdgcn_exp2f(x * __builtin_fmaf(x * x, C1, C0));
    return __builtin_fmaf(-x, __builtin_amdgcn_rcpf(1.f + e), x);
}
__device__ __forceinline__ unsigned pk4_fp8(float a, float b, float c, float d) { int w = 0; w = __builtin_amdgcn_cvt_pk_fp8_f32(a, b, w, false); w = __builtin_amdgcn_cvt_pk_fp8_f32(c, d, w, true); return (unsigned)w; }
__device__ __forceinline__ float clamp448(float x) { return __builtin_amdgcn_fmed3f(x, -448.f, 448.f); }
#define VM_WAIT() asm volatile("s_waitcnt vmcnt(0)" ::: "memory")
#define LDS_WAIT() asm volatile("s_waitcnt lgkmcnt(0)" ::: "memory")

#define XB_TMO      128
#define XB_XCNT(j)  (256  + 64 * (j))
#define XB_XSUB(j)  (1280 + 64 * (j))
#define XB_XGEN(j)  (2304 + 64 * (j))
#define XB_TOP      3328
#define XB_TOPGEN   3392
#define XCD_BAR_WORDS 3456
#define XB_SPIN_CAP (1u << 18)

__device__ __forceinline__ unsigned xb_ld(unsigned* p)              { return __hip_atomic_load(p, __ATOMIC_RELAXED, __HIP_MEMORY_SCOPE_AGENT); }
__device__ __forceinline__ unsigned xb_add(unsigned* p, unsigned v) { return __hip_atomic_fetch_add(p, v, __ATOMIC_RELAXED, __HIP_MEMORY_SCOPE_AGENT); }
__device__ __forceinline__ unsigned xb_xcc_id() { return (unsigned)__builtin_amdgcn_s_getreg((3 << 11) | 20) & 0xFu; }
#define XB_SPIN(cond, bar) do { unsigned _sp = 0; while (cond) { __builtin_amdgcn_s_sleep(1); \
    if ((++_sp & 255u) == 0u) { if (xb_ld(&(bar)[XB_TMO])) break; if (_sp > XB_SPIN_CAP) { atomicAdd(&(bar)[XB_TMO], 1u); break; } } } } while (0)

struct XcdBarrier { unsigned* bar; unsigned x; volatile LAS unsigned* st; };

__device__ __forceinline__ XcdBarrier xcd_barrier_post(unsigned* bar, volatile LAS unsigned* st) {
    XcdBarrier b; b.bar = bar; b.x = xb_xcc_id(); b.st = st;
    if (threadIdx.x == 0) (void)xb_add(&bar[XB_XCNT(b.x)], 1u);
    return b;
}
__device__ __forceinline__ void xcd_barrier_complete(unsigned* bar, unsigned x, unsigned& nloc, unsigned& nx) {
    const unsigned G = gridDim.x * gridDim.y * gridDim.z;
    unsigned sum, cnt, mine, sp = 0u;
    for (;;) {
        sum = 0u; cnt = 0u; mine = 0u;
#pragma unroll
        for (unsigned j = 0; j < 16; ++j) { const unsigned c = xb_ld(&bar[XB_XCNT(j)]); sum += c; cnt += (c > 0u) ? 1u : 0u; mine = (j == x) ? c : mine; }
        if (sum == G) break;
        __builtin_amdgcn_s_sleep(1);
        if ((++sp & 255u) == 0u) { if (xb_ld(&bar[XB_TMO])) break; if (sp > XB_SPIN_CAP) { atomicAdd(&bar[XB_TMO], 1u); break; } }
    }
    nloc = mine > 0u ? mine : 1u; nx = cnt > 0u ? cnt : 1u;
}
__device__ __forceinline__ void xcd_barrier(const XcdBarrier& b) {
    asm volatile("s_waitcnt vmcnt(0)" ::: "memory");
    __syncthreads();
    if (threadIdx.x == 0) {
        unsigned* bar = b.bar;
        __builtin_amdgcn_s_waitcnt(0);
        unsigned nloc = b.st[0], nx = b.st[1];
        if (nloc == 0u) { xcd_barrier_complete(bar, b.x, nloc, nx); b.st[0] = nloc; b.st[1] = nx; }
        const unsigned old = xb_add(&bar[XB_XSUB(b.x)], 1u);
        const unsigned gen = old / nloc;
        if (old + 1u == (gen + 1u) * nloc) {
            __builtin_amdgcn_fence(__ATOMIC_RELEASE, "agent");
            asm volatile("s_waitcnt vmcnt(0)" ::: "memory");
            const unsigned og = xb_add(&bar[XB_TOP], 1u);
            const unsigned tg = og / nx;
            if (og + 1u == (tg + 1u) * nx) xb_add(&bar[XB_TOPGEN], 1u);
            else XB_SPIN(xb_ld(&bar[XB_TOPGEN]) == tg, bar);
            __builtin_amdgcn_fence(__ATOMIC_ACQUIRE, "agent");
            xb_add(&bar[XB_XGEN(b.x)], 1u);
            asm volatile("s_waitcnt vmcnt(0)" ::: "memory");
        } else {
            __builtin_amdgcn_fence(__ATOMIC_ACQUIRE, "agent");
            XB_SPIN(xb_ld(&bar[XB_XGEN(b.x)]) == gen, bar);
            asm volatile("s_waitcnt vmcnt(0)" ::: "memory");
        }
    }
    __syncthreads();
}

constexpr int CW_GRP = 16384, CW_XID = 20480;
__device__ __forceinline__ void group_barrier(unsigned* ctl, int group, unsigned target, volatile LAS unsigned* st) {
    asm volatile("s_waitcnt vmcnt(0)" ::: "memory");
    __syncthreads();
    if (threadIdx.x == 0) {
        unsigned* c = ctl + CW_GRP + group * 16; unsigned* bar = ctl + CW_BAR;
        unsigned same = st[0];
        if (same == 0u) { unsigned* xi = ctl + CW_XID + group * 4; const unsigned i0 = xb_ld(xi), i1 = xb_ld(xi + 1), i2 = xb_ld(xi + 2), i3 = xb_ld(xi + 3); same = (i0 != 0u && i0 == i1 && i0 == i2 && i0 == i3) ? 2u : 1u; st[0] = same; }
        if (same == 2u) __builtin_amdgcn_fence(__ATOMIC_RELEASE, "workgroup"); else __builtin_amdgcn_fence(__ATOMIC_RELEASE, "agent");
        asm volatile("s_waitcnt vmcnt(0)" ::: "memory");
        (void)xb_add(c, 1u);
        __builtin_amdgcn_fence(__ATOMIC_ACQUIRE, "agent");
        XB_SPIN(xb_ld(c) < target, bar);
        asm volatile("s_waitcnt vmcnt(0)" ::: "memory");
    }
    __syncthreads();
}

namespace g8 {
constexpr int BM = 256, BK = 64, HALF = 128, HTB = HALF * BK * 2, STAGE_BYTES = 8 * HTB;
__device__ __forceinline__ int lds_byte(int r, int c) { const int st = (r >> 4) * 2 + (c >> 5), rr = r & 15, cc = c & 31, ob = rr * 64 + cc * 2; return st * 1024 + (ob ^ (((ob >> 9) & 1) << 5)); }
__device__ __forceinline__ int perm32(int rho) { const int n = rho >> 4, i = rho & 15; return 8 * (i >> 2) + 4 * n + (i & 3); }
__device__ __forceinline__ void stage_rc(int b, int& R, int& C) { const int st = b / 1024, sb = b % 1024, swz = sb ^ (((sb >> 9) & 1) << 5); R = (st >> 1) * 16 + swz / 64; C = (st & 1) * 32 + (swz % 64) / 2; }

enum Kind { K_RGIN = 0, K_RGGATE, K_RESID, K_PLAIN, K_FTCH, K_FTSEQ, K_FFN1, K_FFN2, K_PLE, K_PP };
struct Desc {
    int kind, K, lda, ldb, nM, nN, ldo, esz;
    const int* gidx;
    int u0, ustride;
    int grp;
    int sc_w, sc_a;
    const void* A; const void* Bt;
    void* o0; void* o1;
    const void* p0; const void* p1; const void* p2;
};
struct Tile { const char* a; const char* b; int pm, pn; };

__device__ __forceinline__ bool get_tile(const Desc& d, int i, Tile& t) {
    const int nunits = d.nM * d.nN;
    int pm, pn;
    if (d.grp) { const int bx = d.u0, v = (bx & 7) * 32 + (bx >> 3), q4 = d.nN >> 2, lg = q4 >> 1;
        if (i >= q4 * (d.nM >> 6)) return false;
        pm = (v >> 2) + 64 * (i >> lg); pn = (v & 3) + 4 * (i & (q4 - 1)); }
    else {
    const long L = (long)i * d.ustride + d.u0; if (d.u0 < 0 || L >= nunits) return false;
    int w = (int)L; { const int q = nunits / 8, r = nunits % 8, xcd = w % 8, off = w / 8; w = (xcd < r ? xcd * (q + 1) : r * (q + 1) + (xcd - r) * q) + off; }
    const int nig = 8 * d.nN, gid = w / nig, fm = gid * 8, gsz = (d.nM - fm) < 8 ? (d.nM - fm) : 8;
    pm = fm + ((w % nig) % gsz); pn = (w % nig) / gsz; }
    t.pm = pm; t.pn = pn;
    size_t arow = (size_t)pm * 256, acol = 0, brow = (size_t)pn * 256, bcol = 0;
    switch (d.kind) {
        case K_RGGATE: acol = (size_t)(pn >> 2) * 256; break;
        case K_FTCH:   arow = (size_t)(pm & 1) * 256; brow = ((size_t)(pm >> 3) * 2 + (pm & 1)) * 2048 + (size_t)pn * 256; bcol = (size_t)((pm >> 1) & 3) * 256; break;
        case K_FTSEQ:  arow = (size_t)(pm & 15) * 256; brow = (size_t)(pm >> 4) * 1024 + (size_t)pn * 256; bcol = (size_t)((pm & 15) >> 2) * KQ; break;
        case K_FFN1:   brow = (size_t)(pm >> 3) * 4096 + (size_t)pn * 256; break;
        case K_FFN2:   brow = (size_t)(pm >> 3) * 1024 + (size_t)pn * 256; break;
        case K_PP:     brow = (size_t)(pm >> 6) * 1024 + (size_t)pn * 256; break;
        default: break;
    }
    t.a = (const char*)d.A + (arow * d.lda + acol) * d.esz; t.b = (const char*)d.Bt + (brow * d.ldb + bcol) * d.esz;
    return true;
}

typedef f32x4 Acc[2][2][4][2];
__device__ __forceinline__ void load_bf16x8(const bf16* p, f32x4& v0, f32x4& v1) { const u32x4 w = *(const u32x4*)p; v0 = (f32x4){bf_lo(w.x), bf_hi(w.x), bf_lo(w.y), bf_hi(w.y)}; v1 = (f32x4){bf_lo(w.z), bf_hi(w.z), bf_lo(w.w), bf_hi(w.w)}; }
__device__ __forceinline__ void store_bf16x8(bf16* p, const f32x4 v0, const f32x4 v1) { u32x4 w; w.x = cvt_pk_bf16(v0[0], v0[1]); w.y = cvt_pk_bf16(v0[2], v0[3]); w.z = cvt_pk_bf16(v1[0], v1[1]); w.w = cvt_pk_bf16(v1[2], v1[3]); *(u32x4*)p = w; }
__device__ __forceinline__ void stg16_wt(void* p, const u32x4 w) { asm volatile("global_store_dwordx4 %0, %1, off sc1\n\ts_nop 1" :: "v"(p), "v"(w) : "memory"); }
__device__ __forceinline__ void store_bf16x8_wt(bf16* p, const f32x4 v0, const f32x4 v1) { u32x4 w; w.x = cvt_pk_bf16(v0[0], v0[1]); w.y = cvt_pk_bf16(v0[2], v0[3]); w.z = cvt_pk_bf16(v1[0], v1[1]); w.w = cvt_pk_bf16(v1[2], v1[3]); stg16_wt(p, w); }
__device__ __forceinline__ void store_bf16x4(bf16* p, const f32x4 v) { u32x2 w; w.x = cvt_pk_bf16(v[0], v[1]); w.y = cvt_pk_bf16(v[2], v[3]); *(u32x2*)p = w; }

__device__ __forceinline__ void rows_rs(const float* ssq, int row0, int fq, float (&rs)[2][4]) {
    f32x4 p[2][4];
#pragma unroll
    for (int ai = 0; ai < 2; ++ai)
#pragma unroll
        for (int m = 0; m < 4; ++m) p[ai][m] = *(const f32x4*)(ssq + (size_t)(row0 + ai * 128 + m * 16) * 16 + 4 * fq);
#pragma unroll
    for (int ai = 0; ai < 2; ++ai)
#pragma unroll
        for (int m = 0; m < 4; ++m) { float s = (p[ai][m][0] + p[ai][m][1]) + (p[ai][m][2] + p[ai][m][3]); s += __shfl_xor(s, 16); s += __shfl_xor(s, 32); rs[ai][m] = rsqrtf(s * (1.f / D) + EPS); }
}
#define EPI_FP8_CASES \
    case K_FFN1: { \
        unsigned char* O = (unsigned char*)d.o0 + (size_t)(u.pm * 256 + lr0) * FF + u.pn * 128 + lc0; \
_Pragma("unroll") \
        for (int ai = 0; ai < 2; ++ai) \
_Pragma("unroll") \
            for (int m = 0; m < 4; ++m) \
                { u32x2 w8; \
_Pragma("unroll") \
                for (int n = 0; n < 2; ++n) { const f32x4 g = acc[ai][0][m][n], up = acc[ai][1][m][n]; f32x4 o; \
_Pragma("unroll") \
                    for (int j = 0; j < 4; ++j) o[j] = clamp448((g[j] * up[j]) * __builtin_amdgcn_rcpf(1.f + __builtin_amdgcn_exp2f(g[j]))); \
                    if (n == 0) w8.x = pk4_fp8(o[0], o[1], o[2], o[3]); else w8.y = pk4_fp8(o[0], o[1], o[2], o[3]); } \
                *(u32x2*)(O + (size_t)(ai * 128 + m * 16) * FF) = w8; } \
    } break; \
    case K_FFN2: { \
        const int row0 = u.pm * 256 + lr0; const float* gatev = (const float*)d.p0; unsigned char* O = (unsigned char*)d.o0 + (size_t)row0 * D + u.pn * 256 + lc0; \
        float gv[2][4]; \
_Pragma("unroll") \
        for (int ai = 0; ai < 2; ++ai) \
_Pragma("unroll") \
            for (int m = 0; m < 4; ++m) gv[ai][m] = gatev[row0 + ai * 128 + m * 16]; \
        asm volatile("" : "+v"(gv[0][0]), "+v"(gv[0][1]), "+v"(gv[0][2]), "+v"(gv[0][3]), "+v"(gv[1][0]), "+v"(gv[1][1]), "+v"(gv[1][2]), "+v"(gv[1][3])); \
_Pragma("unroll") \
        for (int ai = 0; ai < 2; ++ai) \
_Pragma("unroll") \
            for (int m = 0; m < 4; ++m) gv[ai][m] *= 64.f; \
_Pragma("unroll") \
        for (int ai = 0; ai < 2; ++ai) \
_Pragma("unroll") \
            for (int m = 0; m < 4; ++m) \
_Pragma("unroll") \
                for (int bj = 0; bj < 2; ++bj) { const f32x4 y0 = acc[ai][bj][m][0] * gv[ai][m], y1 = acc[ai][bj][m][1] * gv[ai][m]; u32x2 w8; \
                    w8.x = pk4_fp8(clamp448(y0[0]), clamp448(y0[1]), clamp448(y0[2]), clamp448(y0[3])); w8.y = pk4_fp8(clamp448(y1[0]), clamp448(y1[1]), clamp448(y1[2]), clamp448(y1[3])); \
                    *(u32x2*)(O + (size_t)(ai * 128 + m * 16) * D + bj * 128) = w8; } \
    } break; \
    case K_PLE: { \
        const size_t o0 = (size_t)(u.pm * 256 + lr0) * D + u.pn * 256 + lc0; bf16* H = (bf16*)d.o0; const bf16* PP = (const bf16*)d.p0; float* ssq = (float*)d.p1; \
_Pragma("unroll") \
        for (int ai = 0; ai < 2; ++ai) \
_Pragma("unroll") \
            for (int mp = 0; mp < 2; ++mp) { u32x4 hw[2][2], pw[2][2]; \
_Pragma("unroll") \
              for (int mm = 0; mm < 2; ++mm) \
_Pragma("unroll") \
                for (int bj = 0; bj < 2; ++bj) { const size_t ro = o0 + (size_t)(ai * 128 + (2 * mp + mm) * 16) * D + bj * 128; hw[mm][bj] = *(const u32x4*)(H + ro); pw[mm][bj] = *(const u32x4*)(PP + ro); } \
              asm volatile("" : "+v"(hw[0][0]), "+v"(hw[0][1]), "+v"(hw[1][0]), "+v"(hw[1][1]), "+v"(pw[0][0]), "+v"(pw[0][1]), "+v"(pw[1][0]), "+v"(pw[1][1])); \
_Pragma("unroll") \
              for (int mm = 0; mm < 2; ++mm) { const int m = 2 * mp + mm; \
                float part = 0.f; \
_Pragma("unroll") \
                for (int bj = 0; bj < 2; ++bj) { const size_t ro = o0 + (size_t)(ai * 128 + m * 16) * D + bj * 128; const f32x4 a0 = acc[ai][bj][m][0], a1 = acc[ai][bj][m][1]; const u32x4 hh = hw[mm][bj], pp = pw[mm][bj]; f32x4 h0, h1; \
                    h0[0] = bf_lo(hh.x) + sigmoidf_(a0[0]) * bf_lo(pp.x); h0[1] = bf_hi(hh.x) + sigmoidf_(a0[1]) * bf_hi(pp.x); h0[2] = bf_lo(hh.y) + sigmoidf_(a0[2]) * bf_lo(pp.y); h0[3] = bf_hi(hh.y) + sigmoidf_(a0[3]) * bf_hi(pp.y); \
                    h1[0] = bf_lo(hh.z) + sigmoidf_(a1[0]) * bf_lo(pp.z); h1[1] = bf_hi(hh.z) + sigmoidf_(a1[1]) * bf_hi(pp.z); h1[2] = bf_lo(hh.w) + sigmoidf_(a1[2]) * bf_lo(pp.w); h1[3] = bf_hi(hh.w) + sigmoidf_(a1[3]) * bf_hi(pp.w); \
                    store_bf16x8(H + ro, h0, h1); part += ((h0[0] * h0[0] + h0[1] * h0[1]) + (h0[2] * h0[2] + h0[3] * h0[3])) + ((h1[0] * h1[0] + h1[1] * h1[1]) + (h1[2] * h1[2] + h1[3] * h1[3])); } \
                part += __shfl_xor(part, 16); part += __shfl_xor(part, 32); \
                if (fq == 0) ssq[(size_t)(u.pm * 256 + lr0 + ai * 128 + m * 16) * 16 + u.pn * 4 + wc] = part; } } \
    } break;

template <bool FP8>
__device__ __forceinline__ void epilogue(const Desc& d, const Acc& acc, const Tile& u) {
    int tz = threadIdx.x; asm volatile("" : "+v"(tz));
    const int wid = tz >> 6, lane = tz & 63, wr = wid >> 2, wc = wid & 3, fr = lane & 15, fq = lane >> 4;
    const int lr0 = wr * 64 + fr, lc0 = wc * 32 + 8 * fq;
    if constexpr (FP8) {
    switch (d.kind) {
    EPI_FP8_CASES
    default: break;
    }
    } else {
    switch (d.kind) {
    case K_RGIN: {
        const int row0 = u.pm * 256 + lr0, col0 = u.pn * 256 + lc0; const bool isg = u.pn < 4;
        bf16* O = isg ? (bf16*)d.o0 : (bf16*)d.o1; const int oc0 = isg ? col0 : col0 - 1024; const float* bias = (const float*)d.p0; const float* ssq = (const float*)d.p1;
        float rs[2][4]; f32x4 bv[2][2];
        rows_rs(ssq, row0, fq, rs);
#pragma unroll
        for (int bj = 0; bj < 2; ++bj)
#pragma unroll
            for (int n = 0; n < 2; ++n) bv[bj][n] = *(const f32x4*)(bias + col0 + bj * 128 + n * 4);
#pragma unroll
        for (int ai = 0; ai < 2; ++ai)
#pragma unroll
            for (int m = 0; m < 4; ++m)
#pragma unroll
                for (int bj = 0; bj < 2; ++bj) { f32x4 v[2];
#pragma unroll
                    for (int n = 0; n < 2; ++n) { v[n] = acc[ai][bj][m][n] * rs[ai][m] + bv[bj][n];
                        if (isg) { v[n][0] = gelu_tanh(v[n][0]); v[n][1] = gelu_tanh(v[n][1]); v[n][2] = gelu_tanh(v[n][2]); v[n][3] = gelu_tanh(v[n][3]); } }
                    store_bf16x8_wt(O + (size_t)(row0 + ai * 128 + m * 16) * D + oc0 + bj * 128, v[0], v[1]); }
    } break;
    case K_RGGATE: {
        const int head = u.pn >> 2, q = u.pn & 3, dr = q >> 1, c2 = q & 1;
        const int row0 = u.pm * 256 + lr0, ch0 = head * 256 + c2 * 128 + lc0;
        const float* gxb = (const float*)d.p0 + dr * 1024; const float* gab = (const float*)d.p1 + dr * 1024; const float* lam = (const float*)d.p2 + dr * 1024;
        bf16* la = (bf16*)d.o0 + (size_t)dr * T * D; bf16* bb = (bf16*)d.o1 + (size_t)dr * T * D; const bf16* UF = (const bf16*)d.A;
        f32x4 nbx[2], nba[2], sp[2], sp2[2];
#pragma unroll
        for (int n = 0; n < 2; ++n) { const f32x4 bx = *(const f32x4*)(gxb + ch0 + 4 * n), ba = *(const f32x4*)(gab + ch0 + 4 * n), lm = *(const f32x4*)(lam + ch0 + 4 * n);
#pragma unroll
            for (int j = 0; j < 4; ++j) { const float y = __expf(-lm[j]); sp[n][j] = -8.f * ((y < 0.03f) ? y * (1.f + y * (-0.5f + y * ((1.f / 3.f) - 0.25f * y))) : logf(1.f + y));
                sp2[n][j] = 2.f * L2E * sp[n][j]; nbx[n][j] = -L2E * bx[j]; nba[n][j] = -L2E * ba[j]; } }
#pragma unroll
        for (int ai = 0; ai < 2; ++ai) { u32x4 uw[4];
#pragma unroll
            for (int m = 0; m < 4; ++m) uw[m] = *(const u32x4*)(UF + (size_t)(row0 + ai * 128 + m * 16) * D + ch0);
#pragma unroll
            for (int m = 0; m < 4; ++m) { const size_t ro = (size_t)(row0 + ai * 128 + m * 16) * D + ch0;
                const float uf[2][4] = {{bf_lo(uw[m].x), bf_hi(uw[m].x), bf_lo(uw[m].y), bf_hi(uw[m].y)}, {bf_lo(uw[m].z), bf_hi(uw[m].z), bf_lo(uw[m].w), bf_hi(uw[m].w)}};
                f32x4 lo[2], bo[2];
#pragma unroll
                for (int n = 0; n < 2; ++n)
#pragma unroll
                    for (int j = 0; j < 4; ++j) {
                        const float it = __builtin_amdgcn_rcpf(1.f + __builtin_amdgcn_exp2f(__builtin_fmaf(acc[ai][0][m][n][j], -L2E, nbx[n][j])));
                        const float rt = __builtin_amdgcn_rcpf(1.f + __builtin_amdgcn_exp2f(__builtin_fmaf(acc[ai][1][m][n][j], -L2E, nba[n][j])));
                        const float em = 1.f - __builtin_amdgcn_exp2f(sp2[n][j] * rt);
                        lo[n][j] = sp[n][j] * rt; bo[n][j] = __builtin_amdgcn_sqrtf(em) * (it * uf[n][j]); }
                store_bf16x8(la + ro, lo[0], lo[1]); store_bf16x8(bb + ro, bo[0], bo[1]); } }
    } break;
    case K_RESID: {
        const int row0 = u.pm * 256 + lr0, col0 = u.pn * 256 + lc0; bf16* H = (bf16*)d.o0; const float* bias = (const float*)d.p0;
        f32x4 bv[2][2];
#pragma unroll
        for (int bj = 0; bj < 2; ++bj)
#pragma unroll
            for (int n = 0; n < 2; ++n) bv[bj][n] = bias ? *(const f32x4*)(bias + col0 + bj * 128 + n * 4) : (f32x4){0.f, 0.f, 0.f, 0.f};
#pragma unroll
        for (int ai = 0; ai < 2; ++ai) { u32x4 hw[4][2];
#pragma unroll
            for (int m = 0; m < 4; ++m)
#pragma unroll
                for (int bj = 0; bj < 2; ++bj) hw[m][bj] = *(const u32x4*)(H + (size_t)(row0 + ai * 128 + m * 16) * D + col0 + bj * 128);
            asm volatile("" : "+v"(hw[0][0]), "+v"(hw[0][1]), "+v"(hw[1][0]), "+v"(hw[1][1]), "+v"(hw[2][0]), "+v"(hw[2][1]), "+v"(hw[3][0]), "+v"(hw[3][1]));
#pragma unroll
            for (int m = 0; m < 4; ++m)
#pragma unroll
                for (int bj = 0; bj < 2; ++bj) { const u32x4 w = hw[m][bj]; const f32x4 h0 = {bf_lo(w.x), bf_hi(w.x), bf_lo(w.y), bf_hi(w.y)}, h1 = {bf_lo(w.z), bf_hi(w.z), bf_lo(w.w), bf_hi(w.w)};
                    store_bf16x8(H + (size_t)(row0 + ai * 128 + m * 16) * D + col0 + bj * 128, h0 + acc[ai][bj][m][0] + bv[bj][0], h1 + acc[ai][bj][m][1] + bv[bj][1]); } }
    } break;
    case K_PLAIN: case K_FTCH: case K_FTSEQ: case K_PP: {
        int orow = u.pm * 256, ocol = u.pn * 256;
        if (d.kind == K_FTCH) {
            bf16* Oe = (bf16*)d.o0 + (size_t)((u.pm >> 1) * 256 + lr0) * d.ldo + (size_t)(2 * (u.pm & 1)) * KQ + u.pn * 128 + (lc0 >> 1);
#pragma unroll
            for (int ai = 0; ai < 2; ++ai)
#pragma unroll
                for (int m = 0; m < 4; ++m)
#pragma unroll
                    for (int bj = 0; bj < 2; ++bj) { const f32x4 v0 = acc[ai][bj][m][0], v1 = acc[ai][bj][m][1]; bf16* o = Oe + (size_t)(ai * 128 + m * 16) * d.ldo + bj * 64;
                        store_bf16x4(o, (f32x4){v0[0], v0[2], v1[0], v1[2]}); store_bf16x4(o + KQ, (f32x4){v0[1], v0[3], v1[1], v1[3]}); }
            break; }
        bf16* O = (bf16*)d.o0 + (size_t)(orow + lr0) * d.ldo + ocol + lc0; const float* ssq = (const float*)d.p0;
        float rs[2][4];
        if (ssq) rows_rs(ssq, orow + lr0, fq, rs);
        else {
#pragma unroll
            for (int ai = 0; ai < 2; ++ai)
#pragma unroll
                for (int m = 0; m < 4; ++m) rs[ai][m] = 1.f; }
#pragma unroll
        for (int ai = 0; ai < 2; ++ai)
#pragma unroll
            for (int m = 0; m < 4; ++m)
#pragma unroll
                for (int bj = 0; bj < 2; ++bj) store_bf16x8_wt(O + (size_t)(ai * 128 + m * 16) * d.ldo + bj * 128, acc[ai][bj][m][0] * rs[ai][m], acc[ai][bj][m][1] * rs[ai][m]);
    } break;
    default: break;
    }
    }
}
#undef EPI_FP8_CASES

typedef int i32x8 __attribute__((ext_vector_type(8)));
typedef int i32x4 __attribute__((ext_vector_type(4)));
template <bool FP8>
__device__ __forceinline__ void gemm_phase(LAS unsigned char* lds, const Desc& prob) {
    int tid = threadIdx.x; asm volatile("" : "+v"(tid));
    const int wid = __builtin_amdgcn_readfirstlane(tid >> 6), lane = tid & 63, wr = wid >> 2, wc = wid & 3, fr = lane & 15, fq = lane >> 4;
    const int esz = FP8 ? 1 : 2;
    const int nt = prob.K * esz / 128;
    int sc_w = prob.sc_w, sc_a = prob.sc_a; asm volatile("" : "+v"(sc_w), "+v"(sc_a));
    unsigned voffA[2], voffB[2];
#pragma unroll
    for (int i = 0; i < 2; ++i) { int R, C; stage_rc(tid * 16 + i * 8192, R, C); const int Rb = (R & ~31) + perm32(R & 31);
        voffA[i] = (unsigned)(R * prob.lda * esz + C * 2); voffB[i] = (unsigned)(Rb * prob.ldb * esz + C * 2); }
    const size_t kstep = 128;
    const size_t hstepA = (size_t)HALF * prob.lda * esz, hstepB = (size_t)HALF * prob.ldb * esz;
    const unsigned ldsw = (unsigned)wid * 1024u;
    const int aoff = lds_byte(wr * 64 + fr, fq * 8), boff = lds_byte(wc * 32 + fr, fq * 8);
    LAS unsigned* const rtab = (LAS unsigned*)(lds + STAGE_BYTES + 1024);
    unsigned goffC[2][2] = {{0u, 0u}, {0u, 0u}}, goffN[2][2] = {{0u, 0u}, {0u, 0u}}; int gR0 = 0; unsigned gC2 = 0u;
    const bool GAT = FP8 && prob.gidx != nullptr;
    if (GAT) {
        int grow[4], gval[4];
#pragma unroll
        for (int q = 0; q < 4; ++q) { const int uu = __builtin_amdgcn_readfirstlane((tid >> 8) + 2 * q), r = tid & 255; Tile tt;
            grow[q] = get_tile(prob, uu, tt) ? tt.pm * 256 + r : -1; gval[q] = prob.gidx[grow[q] < 0 ? 0 : grow[q]]; }
        asm volatile("" : "+v"(gval[0]), "+v"(gval[1]), "+v"(gval[2]), "+v"(gval[3]));
#pragma unroll
        for (int q = 0; q < 4; ++q) { const int uu = __builtin_amdgcn_readfirstlane((tid >> 8) + 2 * q), r = tid & 255;
            if (grow[q] >= 0) rtab[uu * 256 + r] = (unsigned)(((grow[q] >> 9) & 3) * 4096 + gval[q]) * (unsigned)prob.lda; }
        __syncthreads();
        { int R, C; stage_rc(tid * 16, R, C); gR0 = R; gC2 = (unsigned)(C * 2); }
    }
#define G8_GOFF(dst, uord) do { _Pragma("unroll") for (int _h = 0; _h < 2; ++_h) _Pragma("unroll") for (int _i = 0; _i < 2; ++_i) dst[_h][_i] = rtab[((uord) & 7) * 256 + _h * 128 + gR0 + 64 * _i] + gC2; } while (0)
#define G8_STGA(bufoff, h, nx, ptr, kb) do { if (GAT) { _Pragma("unroll") for (int _i = 0; _i < 2; ++_i) { const unsigned _o = ((nx) ? goffN[h][_i] : goffC[h][_i]) + (unsigned)(kb); \
            __builtin_amdgcn_global_load_lds((const unsigned*)((const char*)prob.A + _o), (LAS unsigned*)(lds + (bufoff) + ldsw + _i * 8192), 16, 0, 0); } } \
        else { G8_STAGE(bufoff, (ptr) + ((h) ? hstepA : 0), voffA); } } while (0)
#define G8_SA(b, h) (((b) * 2 + (h)) * HTB)
#define G8_SB(b, h) ((4 + (b) * 2 + (h)) * HTB)
#define G8_STAGE(bufoff, gbase, voff) do { _Pragma("unroll") for (int _i = 0; _i < 2; ++_i) \
        __builtin_amdgcn_global_load_lds((const unsigned*)((const char*)(gbase) + (voff)[_i]), (LAS unsigned*)(lds + (bufoff) + ldsw + _i * 8192), 16, 0, 0); } while (0)
#define G8_LDA(dst, b, h) do { _Pragma("unroll") for (int m = 0; m < 4; ++m) _Pragma("unroll") for (int k = 0; k < 2; ++k) dst[m][k] = *(const LAS i32x4*)(lds + G8_SA(b, h) + aoff + m * 2048 + k * 1024); } while (0)
#define G8_LDB(dst, b, h) do { _Pragma("unroll") for (int n = 0; n < 2; ++n) _Pragma("unroll") for (int k = 0; k < 2; ++k) dst[n][k] = *(const LAS i32x4*)(lds + G8_SB(b, h) + boff + n * 2048 + k * 1024); } while (0)
#define G8_CAT(v) __builtin_shufflevector(v[0], v[1], 0, 1, 2, 3, 4, 5, 6, 7)
#define G8_MMA(ai, bj, At, Bt) do { __builtin_amdgcn_s_setprio(1); \
        if constexpr (FP8) { _Pragma("unroll") for (int m = 0; m < 4; ++m) _Pragma("unroll") for (int n = 0; n < 2; ++n) { const i32x8 _w = G8_CAT(Bt[n]), _x = G8_CAT(At[m]); \
            asm volatile("s_nop 1\n\tv_mfma_scale_f32_16x16x128_f8f6f4 %0, %1, %2, %0, %3, %4 op_sel_hi:[0,0,0]" : "+v"(acc[ai][bj][m][n]) : "v"(_w), "v"(_x), "v"(sc_w), "v"(sc_a)); } } \
        else { _Pragma("unroll") for (int m = 0; m < 4; ++m) _Pragma("unroll") for (int n = 0; n < 2; ++n) _Pragma("unroll") for (int k = 0; k < 2; ++k) \
            acc[ai][bj][m][n] = __builtin_amdgcn_mfma_f32_16x16x32_bf16((bf16x8)Bt[n][k], (bf16x8)At[m][k], acc[ai][bj][m][n], 0, 0, 0); } \
        __builtin_amdgcn_s_setprio(0); } while (0)
#define G8_WAIT_V(n) asm volatile("s_waitcnt vmcnt(" #n ")" ::: "memory")
#define G8_WAIT_L(n) asm volatile("s_waitcnt lgkmcnt(" #n ")" ::: "memory")
#define G8_BAR __builtin_amdgcn_s_barrier()
#define G8_SCHED __builtin_amdgcn_sched_barrier(0)
    Tile cur, nxt; int ui = 0;
    if (!get_tile(prob, 0, cur)) return;
    Acc acc;
#pragma unroll
    for (int a = 0; a < 2; ++a)
#pragma unroll
        for (int b = 0; b < 2; ++b)
#pragma unroll
            for (int m = 0; m < 4; ++m)
#pragma unroll
                for (int n = 0; n < 2; ++n) acc[a][b][m][n] = (f32x4){0.f, 0.f, 0.f, 0.f};
    i32x4 At[4][2], B0[2][2], B1[2][2];
    const char* cA = cur.a; const char* cB = cur.b;
    if (GAT) { G8_GOFF(goffC, 0); }
    G8_STAGE(G8_SB(0, 0), cB, voffB); G8_STAGE(G8_SB(0, 1), cB + hstepB, voffB); G8_STGA(G8_SA(0, 0), 0, false, cA, 0); G8_STGA(G8_SA(0, 1), 1, false, cA, 0);
    if (wr == 1) G8_BAR;
    G8_WAIT_V(2); G8_BAR;
    G8_STAGE(G8_SB(1, 0), cB + kstep, voffB); G8_STGA(G8_SA(1, 0), 0, false, cA + kstep, 128); G8_STAGE(G8_SB(1, 1), cB + hstepB + kstep, voffB);
    G8_WAIT_V(6); G8_BAR;
    for (;;) {
        const bool has_next = get_tile(prob, ui + 1, nxt);
        const char* nA = has_next ? nxt.a : cA; const char* nB = has_next ? nxt.b : cB;
        if (GAT) { G8_GOFF(goffN, has_next ? ui + 1 : ui); }
        for (int t = 0; t < nt; t += 2) {
            const bool last = (t == nt - 2);
            const char* a1 = cA + (size_t)(t + 1) * kstep;
            const char* a2 = last ? nA : cA + (size_t)(t + 2) * kstep; const char* b2 = last ? nB : cB + (size_t)(t + 2) * kstep;
            const char* a3 = a2 + kstep; const char* b3 = b2 + kstep;
            G8_LDB(B0, 0, 0); G8_LDB(B1, 0, 1); G8_SCHED; G8_LDA(At, 0, 0); G8_STGA(G8_SA(1, 1), 1, false, a1, (t + 1) * 128);
            G8_WAIT_V(8); G8_WAIT_L(0); G8_BAR; G8_MMA(0, 0, At, B0); G8_MMA(0, 1, At, B1); G8_BAR; G8_SCHED;
            G8_LDA(At, 0, 1); G8_STAGE(G8_SB(0, 0), b2, voffB); G8_STAGE(G8_SB(0, 1), b2 + hstepB, voffB); G8_STGA(G8_SA(0, 0), 0, last, a2, last ? 0 : (t + 2) * 128);
            G8_WAIT_V(8); G8_WAIT_L(0); G8_BAR; G8_MMA(1, 0, At, B0); G8_MMA(1, 1, At, B1); G8_BAR; G8_SCHED;
            G8_LDB(B0, 1, 0); G8_LDB(B1, 1, 1); G8_SCHED; G8_LDA(At, 1, 0); G8_STGA(G8_SA(0, 1), 1, last, a2, last ? 0 : (t + 2) * 128);
            G8_WAIT_V(8); G8_WAIT_L(0); G8_BAR; G8_MMA(0, 0, At, B0); G8_MMA(0, 1, At, B1); G8_BAR; G8_SCHED;
            G8_LDA(At, 1, 1); G8_STAGE(G8_SB(1, 0), b3, voffB); G8_STAGE(G8_SB(1, 1), b3 + hstepB, voffB); G8_STGA(G8_SA(1, 0), 0, last, a3, last ? 128 : (t + 3) * 128);
            G8_WAIT_V(8); G8_WAIT_L(0); G8_BAR; G8_MMA(1, 0, At, B0); G8_MMA(1, 1, At, B1); G8_BAR; G8_SCHED;
        }
        if (wr == 0) G8_BAR;
        if (FP8) asm volatile("s_nop 15\n\ts_nop 15" ::: "memory");
        epilogue<FP8>(prob, acc, cur);
        if (!has_next) break;
#pragma unroll
        for (int a = 0; a < 2; ++a)
#pragma unroll
            for (int b = 0; b < 2; ++b)
#pragma unroll
                for (int m = 0; m < 4; ++m)
#pragma unroll
                    for (int n = 0; n < 2; ++n) acc[a][b][m][n] = (f32x4){0.f, 0.f, 0.f, 0.f};
        cur = nxt; cA = nA; cB = nB; ++ui;
        if (GAT) {
#pragma unroll
            for (int _h = 0; _h < 2; ++_h)
#pragma unroll
                for (int _i = 0; _i < 2; ++_i) goffC[_h][_i] = goffN[_h][_i]; }
        if (wr == 1) G8_BAR;
    }
    G8_WAIT_V(0);
    G8_BAR;
#undef G8_SA
#undef G8_SB
#undef G8_STAGE
#undef G8_STGA
#undef G8_GOFF
#undef G8_LDA
#undef G8_LDB
#undef G8_CAT
#undef G8_MMA
#undef G8_WAIT_V
#undef G8_WAIT_L
#undef G8_BAR
#undef G8_SCHED
}
}

struct Args { const float* in[25]; float* out; unsigned char* ws; int ph_lo, ph_hi; };
struct Ctx {
    LAS unsigned char* lds;
    int tid, lane, wave, G, gw, NGW, z;
};
__device__ __forceinline__ int opaque_zero() { int z; asm volatile("s_mov_b32 %0, 0" : "=s"(z)); return z; }
__device__ __forceinline__ Ctx make_ctx(LAS unsigned char* lds) {
    Ctx F; F.lds = lds; F.z = opaque_zero();
    int tz = threadIdx.x; asm volatile("" : "+v"(tz));
    F.tid = tz; F.lane = tz & 63; F.wave = __builtin_amdgcn_readfirstlane(tz >> 6);
    F.G = gridDim.x; { const int bx = blockIdx.x; const int vcu = (F.G % 8 == 0) ? (bx % 8) * (F.G / 8) + bx / 8 : bx; F.gw = vcu * NWAVES + F.wave; }
    F.NGW = F.G * NWAVES;
    return F;
}
#define WSP(T_, off) ((T_*)(args.ws + ((size_t)(off) + (size_t)F.z)))
#define INP(k) (args.in[(k) + F.z])
#define CTXA LAS unsigned char* lds_, const Args& args
#define CTX_LOCAL() const Ctx F = make_ctx(lds_)

__device__ __forceinline__ void tr_item(const float* W, int K, int N, bf16* WT, int drow0, LAS float* scr, int k0, int n0, int lane, const float* ks) {
#pragma unroll 8
    for (int i = 0; i < 32; ++i) { const int kk = 2 * i + (lane >> 5); scr[kk * 33 + (lane & 31)] = __builtin_nontemporal_load(W + (size_t)(k0 + kk) * N + n0 + (lane & 31)) * (ks ? ks[k0 + kk] : 1.f); }
    LDS_WAIT(); asm volatile("" ::: "memory");
    const int c = lane & 7;
#pragma unroll
    for (int j = 0; j < 4; ++j) { const int n = (lane >> 3) + 8 * j; const LAS float* s = scr + (8 * c) * 33 + n;
        u32x4 o; o.x = cvt_pk_bf16(s[0 * 33], s[1 * 33]); o.y = cvt_pk_bf16(s[2 * 33], s[3 * 33]); o.z = cvt_pk_bf16(s[4 * 33], s[5 * 33]); o.w = cvt_pk_bf16(s[6 * 33], s[7 * 33]);
        *(u32x4*)(WT + (size_t)(drow0 + n) * K + k0 + 8 * c) = o; }
    LDS_WAIT(); asm volatile("" ::: "memory");
}

__device__ __forceinline__ void tr_item8(const float* W, int K, int N, unsigned char* WT, int drow0, LAS float* scr, int k0, int n0, int lane, float sc) {
#pragma unroll 8
    for (int i = 0; i < 32; ++i) { const int kk = 2 * i + (lane >> 5); scr[kk * 33 + (lane & 31)] = __builtin_nontemporal_load(W + (size_t)(k0 + kk) * N + n0 + (lane & 31)); }
    LDS_WAIT(); asm volatile("" ::: "memory");
    const int c = lane & 7;
#pragma unroll
    for (int j = 0; j < 4; ++j) { const int n = (lane >> 3) + 8 * j; const LAS float* s = scr + (8 * c) * 33 + n;
        u32x2 o; o.x = pk4_fp8(clamp448(sc * s[0 * 33]), clamp448(sc * s[1 * 33]), clamp448(sc * s[2 * 33]), clamp448(sc * s[3 * 33]));
        o.y = pk4_fp8(clamp448(sc * s[4 * 33]), clamp448(sc * s[5 * 33]), clamp448(sc * s[6 * 33]), clamp448(sc * s[7 * 33]));
        __builtin_nontemporal_store(o, (u32x2*)(WT + (size_t)(drow0 + n) * K + k0 + 8 * c)); }
    LDS_WAIT(); asm volatile("" ::: "memory");
}

__device__ __forceinline__ void p0_prologue(CTXA) {
    CTX_LOCAL();
    LAS float* scr = (LAS float*)(F.lds + F.wave * 16384);
    constexpr int I_EXP = 1024;
    constexpr int N_GU = DEPTH * NE * 2 * I_EXP;
    constexpr int N_DN = DEPTH * NE * I_EXP;
    constexpr int N_WIN = 2 * 1024;
    constexpr int N_SQ = 10 * 512;
    constexpr int N_GT = 32 * 32;
    constexpr int N_PP = 4 * 128;
    constexpr int NITEMS = N_GU + N_DN + N_WIN + N_SQ + N_GT + N_PP;
    for (int it = F.gw; it < NITEMS; it += F.NGW) {
        int r = it; const float* src; bf16* dst; int K, N, k0, n0, drow0; const float* ks = nullptr;
        if (r < N_GU) { const int m = r >> 10, q = r & 1023, which = m & 1, le = m >> 1;
            const int k0e = (q >> 6) * 64, n0e = (q & 63) * 32;
            tr_item8(INP(which ? 21 : 20) + (size_t)le * 1024 * 2048, 1024, 2048, WSP(unsigned char, WS_W1T) + (size_t)le * 4096 * 1024, (n0e >> 7) * 256 + which * 128 + (n0e & 127), scr, k0e, n0e, F.lane, which ? (-512.f * 4.f / L2E) : (-512.f * L2E)); continue; }
        else if ((r -= N_GU) < N_DN) { const int le = r >> 10, q = r & 1023;
            const int k0e = (q >> 5) * 64, n0e = (q & 31) * 32;
            tr_item8(INP(22) + (size_t)le * 2048 * 1024, 2048, 1024, WSP(unsigned char, WS_W2T) + (size_t)le * 1024 * 2048, n0e, scr, k0e, n0e, F.lane, 512.f); continue; }
        else if ((r -= N_DN) < N_WIN) { const int j = r >> 10, q = r & 1023;
            src = INP(6) + (size_t)j * 1024 * 2048; dst = WSP(bf16, WS_WINT) + (size_t)j * 2048 * 1024; K = 1024; N = 2048; ks = INP(2) + (size_t)(2 * j) * D;
            k0 = (q >> 6) * 64; n0 = (q & 63) * 32; drow0 = n0; }
        else if ((r -= N_WIN) < N_SQ) { const int mi = r >> 9, q = r & 511; K = 1024; N = 1024; k0 = (q >> 5) * 64; n0 = (q & 31) * 32; drow0 = n0;
            if (mi < 2) { src = INP(15) + (size_t)mi * 1048576; dst = WSP(bf16, WS_WOUTT) + (size_t)mi * 1048576; }
            else if (mi < 4) { src = INP(17) + (size_t)(mi - 2) * 1048576; dst = WSP(bf16, WS_FTINT) + (size_t)(mi - 2) * 1048576; ks = INP(2) + (size_t)(2 * (mi - 2) + 1) * D; }
            else if (mi < 6) { src = INP(18) + (size_t)(mi - 4) * 1048576; dst = WSP(bf16, WS_FTOUTT) + (size_t)(mi - 4) * 1048576; }
            else { tr_item8(INP(24) + (size_t)(mi - 6) * 1048576, 1024, 1024, WSP(unsigned char, WS_PLEGT) + (size_t)(mi - 6) * 1048576, n0, scr, k0, n0, F.lane, 512.f); continue; } }
        else if ((r -= N_SQ) < N_GT) { const int mi = r >> 5, q = r & 31;
            const int head = mi & 3, d = (mi >> 2) & 1, j = (mi >> 3) & 1, which = mi >> 4;
            src = INP(which ? 12 : 10) + (size_t)((j * 2 + d) * 4 + head) * 65536; dst = WSP(bf16, WS_GATET) + (size_t)(j * 4 + head) * 1024 * 256; K = 256; N = 256;
            k0 = (q >> 3) * 64; n0 = (q & 7) * 32; drow0 = ((d * 2 + (n0 >> 7)) * 2 + which) * 128 + (n0 & 127); }
        else { r -= N_GT; const int li = r >> 7, q = r & 127;
            src = INP(23) + (size_t)li * 256 * 1024; dst = WSP(bf16, WS_PLEPT) + (size_t)li * 1024 * 256; K = 256; N = 1024;
            k0 = (q >> 5) * 64; n0 = (q & 31) * 32; drow0 = n0; }
        tr_item(src, K, N, dst, drow0, scr, k0, n0, F.lane, ks);
    }
    { const float* X = INP(0); bf16* HB = WSP(bf16, WS_HB); float* SSQ = WSP(float, WS_SSQ);
      for (int row0 = F.gw; row0 < T; row0 += 2 * F.NGW) { f32x4 xv[2][4];
#pragma unroll
          for (int rr = 0; rr < 2; ++rr)
#pragma unroll
              for (int j = 0; j < 4; ++j) xv[rr][j] = __builtin_nontemporal_load((const f32x4*)(X + (size_t)(row0 + rr * F.NGW) * D + 4 * F.lane + 256 * j));
          asm volatile("" : "+v"(xv[0][0]), "+v"(xv[0][1]), "+v"(xv[0][2]), "+v"(xv[0][3]), "+v"(xv[1][0]), "+v"(xv[1][1]), "+v"(xv[1][2]), "+v"(xv[1][3]));
#pragma unroll
          for (int rr = 0; rr < 2; ++rr) { const int row = row0 + rr * F.NGW; float ss = 0.f;
#pragma unroll
              for (int j = 0; j < 4; ++j) { const size_t o = (size_t)row * D + 4 * F.lane + 256 * j; const f32x4 v = xv[rr][j];
                  u32x2 w; w.x = cvt_pk_bf16(v[0], v[1]); w.y = cvt_pk_bf16(v[2], v[3]); *(u32x2*)(HB + o) = w; ss += (v[0] * v[0] + v[1] * v[1]) + (v[2] * v[2] + v[3] * v[3]); }
              ss = wave_sum(ss); if (F.lane < 16) SSQ[(size_t)row * 16 + F.lane] = F.lane ? 0.f : ss; } } }
    const size_t gt = (size_t)blockIdx.x * NTHREADS + F.tid, NGT = (size_t)F.G * NTHREADS;
    { const float* p = INP(1); bf16* o = WSP(bf16, WS_PBF);
      for (size_t i0 = gt; i0 < (size_t)DEPTH * T * PLE / 8; i0 += 4 * NGT) { f32x4 pa[4], pb[4];
#pragma unroll
          for (int q = 0; q < 4; ++q) { const size_t i = i0 + q * NGT; const bool ok = i < (size_t)DEPTH * T * PLE / 8; const size_t ii = ok ? i : i0;
              pa[q] = __builtin_nontemporal_load((const f32x4*)(p + ii * 8)); pb[q] = __builtin_nontemporal_load((const f32x4*)(p + ii * 8 + 4)); }
          asm volatile("" : "+v"(pa[0]), "+v"(pa[1]), "+v"(pa[2]), "+v"(pa[3]), "+v"(pb[0]), "+v"(pb[1]), "+v"(pb[2]), "+v"(pb[3]));
#pragma unroll
          for (int q = 0; q < 4; ++q) { const size_t i = i0 + q * NGT; if (i < (size_t)DEPTH * T * PLE / 8) { const f32x4 a = pa[q], b = pb[q];
              u32x4 w; w.x = cvt_pk_bf16(a[0], a[1]); w.y = cvt_pk_bf16(a[2], a[3]); w.z = cvt_pk_bf16(b[0], b[1]); w.w = cvt_pk_bf16(b[2], b[3]); *(u32x4*)(o + i * 8) = w; } } } }
    { bf16* o = WSP(bf16, WS_DFTC);
      for (size_t i = gt; i < 512 * 256 / 8; i += NGT) { const int n = (int)(i >> 5), c0 = (int)(i & 31) * 8, l = n & 255; float v[8];
#pragma unroll
          for (int j = 0; j < 8; ++j) { const int mm = (l * (c0 + j)) & 255; const float x = (float)mm * (1.f / 256.f); v[j] = (n < 256) ? __builtin_amdgcn_cosf(x) : __builtin_amdgcn_sinf(x); }
          u32x4 w; w.x = cvt_pk_bf16(v[0], v[1]); w.y = cvt_pk_bf16(v[2], v[3]); w.z = cvt_pk_bf16(v[4], v[5]); w.w = cvt_pk_bf16(v[6], v[7]); *(u32x4*)(o + i * 8) = w; } }
    { bf16* o = WSP(bf16, WS_DFTS);
      for (size_t i = gt; i < (size_t)4096 * (KQ / 8); i += NGT) { const int r = (int)(i / (KQ / 8)), c0 = (int)(i % (KQ / 8)) * 8, ty = r >> 10, k = r & 1023; float v[8];
#pragma unroll
          for (int j = 0; j < 8; ++j) { const int c = c0 + j; const int mm = (k * (2 * (c & 1023) + (ty & 1))) & 4095; const float x = (float)mm * (1.f / 4096.f);
              v[j] = (c < 1024) ? ((ty < 2) ? __builtin_amdgcn_cosf(x) : __builtin_amdgcn_sinf(x)) * (1.f / 1024.f) : (c == 1024 && ty == 0) ? ((k & 1) ? -1.f / 1024.f : 1.f / 1024.f) : 0.f; }
          u32x4 w; w.x = cvt_pk_bf16(v[0], v[1]); w.y = cvt_pk_bf16(v[2], v[3]); w.z = cvt_pk_bf16(v[4], v[5]); w.w = cvt_pk_bf16(v[6], v[7]); *(u32x4*)(o + i * 8) = w; } }
}

__device__ __forceinline__ void final_pass(CTXA) {
    CTX_LOCAL();
    const bf16* H = WSP(bf16, WS_HB); const float* g = INP(5);
    f32x4 gv[4];
#pragma unroll
    for (int j = 0; j < 4; ++j) gv[j] = *(const f32x4*)(g + 4 * F.lane + 256 * j);
    const int vcu = F.gw / NWAVES, ntrip = ((T / 64 - vcu + F.G - 1) / F.G) * 4;
    for (int tp = 0; tp < ntrip; ++tp) { const int row0 = (vcu + (tp >> 2) * F.G) * 64 + 8 * F.wave + 2 * (tp & 3);
        f32x4 v[2][4];
#pragma unroll
        for (int rr = 0; rr < 2; ++rr)
#pragma unroll
            for (int j = 0; j < 4; ++j) { const u32x2 w = *(const u32x2*)(H + (size_t)(row0 + rr) * D + 4 * F.lane + 256 * j); v[rr][j] = (f32x4){bf_lo(w.x), bf_hi(w.x), bf_lo(w.y), bf_hi(w.y)}; }
#pragma unroll
        for (int rr = 0; rr < 2; ++rr) { float ss = 0.f;
#pragma unroll
            for (int j = 0; j < 4; ++j) ss += (v[rr][j][0] * v[rr][j][0] + v[rr][j][1] * v[rr][j][1]) + (v[rr][j][2] * v[rr][j][2] + v[rr][j][3] * v[rr][j][3]);
            const float rs = rsqrtf(wave_sum(ss) * (1.f / D) + EPS);
#pragma unroll
            for (int j = 0; j < 4; ++j) *(f32x4*)(args.out + (size_t)(row0 + rr) * D + 4 * F.lane + 256 * j) = v[rr][j] * rs * gv[j]; }
    }
}
__device__ __forceinline__ void router_pass(CTXA, int layer) {
    CTX_LOCAL();
    unsigned char* XN8 = WSP(unsigned char, WS_XN); const bf16* H = WSP(bf16, WS_HB); float* AFF = WSP(float, WS_AFF);
    const float* g = INP(3) + layer * D; const float* wr = INP(19) + (size_t)layer * D * NE;
    LAS unsigned char* wt = F.lds;
    LAS float* gl = (LAS float*)(F.lds + 98304);
    LAS float* xb = (LAS float*)(F.lds + 98304 + 4096);
    const int fr = F.lane & 15, fq = F.lane >> 4, half = F.wave & 1, pr = F.wave >> 1;
    const int NT16 = T / 16;
    int base = (F.gw / NWAVES) * 4;
    u32x4 hw[8][2];
#define RT_LOAD(tb) do { const bf16* hp_ = H + (size_t)(((tb) + pr) * 16 + fr) * D + 512 * half + 16 * fq; \
        _Pragma("unroll") for (int j = 0; j < 8; ++j) { hw[j][0] = *(const u32x4*)(hp_ + 64 * j); hw[j][1] = *(const u32x4*)(hp_ + 64 * j + 8); } } while (0)
    { float tmp[32];
#pragma unroll
      for (int q4 = 0; q4 < 4; ++q4) { const int it = F.tid + q4 * NTHREADS, e = it & 15, ch = it >> 4, s = ch >> 2, k0 = 64 * (s >> 1) + 16 * (ch & 3) + 8 * (s & 1);
#pragma unroll
          for (int q = 0; q < 8; ++q) tmp[q4 * 8 + q] = wr[(k0 + q) * NE + e]; }
#pragma unroll
      for (int q4 = 0; q4 < 4; ++q4) { const int it = F.tid + q4 * NTHREADS, ch = it >> 4, s = ch >> 2, k0 = 64 * (s >> 1) + 16 * (ch & 3) + 8 * (s & 1);
          const f32x4 g0 = *(const f32x4*)(g + k0), g1 = *(const f32x4*)(g + k0 + 4);
          float w[8], r1[8], r2[8]; unsigned hi[4], lo[4], l2[4];
#pragma unroll
          for (int q = 0; q < 8; ++q) w[q] = tmp[q4 * 8 + q] * (q < 4 ? g0[q] : g1[q - 4]);
#pragma unroll
          for (int q = 0; q < 4; ++q) { hi[q] = cvt_pk_bf16(w[2 * q], w[2 * q + 1]); r1[2 * q] = w[2 * q] - bf_lo(hi[q]); r1[2 * q + 1] = w[2 * q + 1] - bf_hi(hi[q]); }
#pragma unroll
          for (int q = 0; q < 4; ++q) { lo[q] = cvt_pk_bf16(r1[2 * q], r1[2 * q + 1]); r2[2 * q] = r1[2 * q] - bf_lo(lo[q]); r2[2 * q + 1] = r1[2 * q + 1] - bf_hi(lo[q]); }
#pragma unroll
          for (int q = 0; q < 4; ++q) l2[q] = cvt_pk_bf16(r2[2 * q], r2[2 * q + 1]);
          *(LAS u32x4*)(wt + it * 16) = (u32x4){hi[0], hi[1], hi[2], hi[3]}; *(LAS u32x4*)(wt + 32768 + it * 16) = (u32x4){lo[0], lo[1], lo[2], lo[3]}; *(LAS u32x4*)(wt + 65536 + it * 16) = (u32x4){l2[0], l2[1], l2[2], l2[3]}; }
      gl[F.tid] = g[F.tid]; gl[F.tid + NTHREADS] = g[F.tid + NTHREADS]; }
    __syncthreads();
    while (base < NT16) {
        RT_LOAD(base);
        const int row = (base + pr) * 16 + fr;
        f32x4 a0 = {0.f, 0.f, 0.f, 0.f}, a1 = a0, a2 = a0; float ss = 0.f;
#pragma unroll
        for (int j = 0; j < 8; ++j)
#pragma unroll
            for (int t = 0; t < 2; ++t) { const int s = (8 * half + j) * 2 + t; LAS unsigned char* wp = wt + s * 1024 + F.lane * 16;
                const u32x4 w0 = *(const LAS u32x4*)wp, w1 = *(const LAS u32x4*)(wp + 32768), w2 = *(const LAS u32x4*)(wp + 65536); const u32x4 h = hw[j][t];
                a0 = __builtin_amdgcn_mfma_f32_16x16x32_bf16((bf16x8)w0, (bf16x8)h, a0, 0, 0, 0);
                a1 = __builtin_amdgcn_mfma_f32_16x16x32_bf16((bf16x8)w1, (bf16x8)h, a1, 0, 0, 0);
                a2 = __builtin_amdgcn_mfma_f32_16x16x32_bf16((bf16x8)w2, (bf16x8)h, a2, 0, 0, 0);
                ss += ((bf_lo(h.x) * bf_lo(h.x) + bf_hi(h.x) * bf_hi(h.x)) + (bf_lo(h.y) * bf_lo(h.y) + bf_hi(h.y) * bf_hi(h.y))) + ((bf_lo(h.z) * bf_lo(h.z) + bf_hi(h.z) * bf_hi(h.z)) + (bf_lo(h.w) * bf_lo(h.w) + bf_hi(h.w) * bf_hi(h.w))); }
        ss += __shfl_xor(ss, 16); ss += __shfl_xor(ss, 32);
        f32x4 acc = (a2 + a1) + a0;
        LAS float* xp = xb + pr * 384;
        if (half == 1) { xp[F.lane] = acc[0]; xp[64 + F.lane] = acc[1]; xp[128 + F.lane] = acc[2]; xp[192 + F.lane] = acc[3]; xp[256 + F.lane] = ss; } else xp[320 + F.lane] = ss;
        __syncthreads();
        const float rs = rsqrtf((ss + (half == 1 ? xp[320 + F.lane] : xp[256 + F.lane])) * (1.f / D) + EPS), rs8 = __builtin_ldexpf(rs, 3);
#pragma unroll
        for (int j = 0; j < 8; ++j) { const int k = 512 * half + 64 * j + 16 * fq; u32x4 o;
#pragma unroll
            for (int t = 0; t < 2; ++t) { const f32x4 g0 = *(const LAS f32x4*)(gl + k + 8 * t), g1 = *(const LAS f32x4*)(gl + k + 8 * t + 4); const u32x4 h = hw[j][t];
                const unsigned p0 = pk4_fp8(clamp448(bf_lo(h.x) * g0[0] * rs8), clamp448(bf_hi(h.x) * g0[1] * rs8), clamp448(bf_lo(h.y) * g0[2] * rs8), clamp448(bf_hi(h.y) * g0[3] * rs8));
                const unsigned p1 = pk4_fp8(clamp448(bf_lo(h.z) * g1[0] * rs8), clamp448(bf_hi(h.z) * g1[1] * rs8), clamp448(bf_lo(h.w) * g1[2] * rs8), clamp448(bf_hi(h.w) * g1[3] * rs8));
                if (t == 0) { o.x = p0; o.y = p1; } else { o.z = p0; o.w = p1; } }
            g8::stg16_wt(XN8 + (size_t)row * D + k, o); }
        if (half == 0) {
            f32x4 lg; lg[0] = (acc[0] + xp[F.lane]) * rs; lg[1] = (acc[1] + xp[64 + F.lane]) * rs; lg[2] = (acc[2] + xp[128 + F.lane]) * rs; lg[3] = (acc[3] + xp[192 + F.lane]) * rs;
            float mx = fmaxf(fmaxf(lg[0], lg[1]), fmaxf(lg[2], lg[3])); mx = fmaxf(mx, __shfl_xor(mx, 16)); mx = fmaxf(mx, __shfl_xor(mx, 32));
            f32x4 ex; float sum = 0.f;
#pragma unroll
            for (int j = 0; j < 4; ++j) { ex[j] = __expf(lg[j] - mx); sum += ex[j]; }
            sum += __shfl_xor(sum, 16); sum += __shfl_xor(sum, 32);
            const int b = row >> 12, s = row & 4095;
#pragma unroll
            for (int j = 0; j < 4; ++j) AFF[((size_t)(b * NE + 4 * fq + j)) * S + s] = ex[j] / sum;
        }
        base += F.G * 4;
        __syncthreads();
    }
#undef RT_LOAD
}

__device__ __forceinline__ void conv_pass(CTXA, int j) {
    CTX_LOCAL();
    const bf16* U = WSP(bf16, WS_BUFB); bf16* O = WSP(bf16, WS_BUFC);
    const float* cw = INP(8) + (size_t)j * 4 * D; const float* cb = INP(9) + (size_t)j * D;
    const int vcu = F.gw / NWAVES, rsub = F.tid >> 7;
    const int c0 = (F.tid & 127) * 8;
    float tw[4][8], tb[8];
    { const f32x4 b0 = *(const f32x4*)(cb + c0), b1 = *(const f32x4*)(cb + c0 + 4); tb[0] = b0[0]; tb[1] = b0[1]; tb[2] = b0[2]; tb[3] = b0[3]; tb[4] = b1[0]; tb[5] = b1[1]; tb[6] = b1[2]; tb[7] = b1[3]; }
#pragma unroll
    for (int k = 0; k < 4; ++k) { const f32x4 w0 = *(const f32x4*)(cw + k * D + c0), w1 = *(const f32x4*)(cw + k * D + c0 + 4);
        tw[k][0] = w0[0]; tw[k][1] = w0[1]; tw[k][2] = w0[2]; tw[k][3] = w0[3]; tw[k][4] = w1[0]; tw[k][5] = w1[1]; tw[k][6] = w1[2]; tw[k][7] = w1[3]; }
    for (int tp = 0; tp < ((T / 64 - vcu + F.G - 1) / F.G) * 4; ++tp) {
        const int rbase = (vcu + (tp >> 2) * F.G) * 64 + 16 * (tp & 3) + rsub;
        u32x4 uw[4][4];
#pragma unroll
        for (int q = 0; q < 4; ++q) { const int row = rbase + 4 * q, s = row & 4095;
#pragma unroll
            for (int k = 0; k < 4; ++k) { const int ss = s + k - 2; uw[q][k] = (ss >= 0 && ss < S) ? *(const u32x4*)(U + (size_t)(row + k - 2) * D + c0) : (u32x4){0u, 0u, 0u, 0u}; } }
#pragma unroll
        for (int q = 0; q < 4; ++q) { const int row = rbase + 4 * q;
            float a[8];
#pragma unroll
            for (int e = 0; e < 8; ++e) a[e] = tb[e];
#pragma unroll
            for (int k = 0; k < 4; ++k) { const u32x4 x = uw[q][k];
                a[0] += bf_lo(x.x) * tw[k][0]; a[1] += bf_hi(x.x) * tw[k][1]; a[2] += bf_lo(x.y) * tw[k][2]; a[3] += bf_hi(x.y) * tw[k][3];
                a[4] += bf_lo(x.z) * tw[k][4]; a[5] += bf_hi(x.z) * tw[k][5]; a[6] += bf_lo(x.w) * tw[k][6]; a[7] += bf_hi(x.w) * tw[k][7]; }
            u32x4 w; w.x = cvt_pk_bf16(a[0], a[1]); w.y = cvt_pk_bf16(a[2], a[3]); w.z = cvt_pk_bf16(a[4], a[5]); w.w = cvt_pk_bf16(a[6], a[7]); *(u32x4*)(O + (size_t)row * D + c0) = w; }
    }
}

__device__ __forceinline__ void ft_fold_pass(CTXA) {
    CTX_LOCAL();
    const bf16* U = WSP(bf16, WS_BUFA); bf16* UF = WSP(bf16, WS_BUFB); bf16* PQ = WSP(bf16, WS_LA);
    const size_t gt = (size_t)blockIdx.x * NTHREADS + F.tid, NGT = (size_t)F.G * NTHREADS;
    for (size_t i0 = gt; i0 < (size_t)NB * 2048 * (D / 8); i0 += 4 * NGT) {
        u32x4 xs4[4], ys4[4];
#pragma unroll
        for (int q = 0; q < 4; ++q) { const size_t i = i0 + q * NGT; const int c0 = (int)(i & 127) * 8, s = (int)(i >> 7) & 2047, b = (int)(i >> 18);
            xs4[q] = *(const u32x4*)(U + ((size_t)b * S + s) * D + c0); ys4[q] = *(const u32x4*)(U + ((size_t)b * S + ((S - s) & (S - 1))) * D + c0); }
#pragma unroll
        for (int q = 0; q < 4; ++q) { const size_t i = i0 + q * NGT; const int c0 = (int)(i & 127) * 8, s = (int)(i >> 7) & 2047, b = (int)(i >> 18);
            const u32x4 x = xs4[q], y = ys4[q];
            const unsigned xs[4] = {x.x, x.y, x.z, x.w}, ys[4] = {y.x, y.y, y.z, y.w}; unsigned ps[4], ms[4];
#pragma unroll
            for (int qq = 0; qq < 4; ++qq) { const float a0 = bf_lo(xs[qq]), a1 = bf_hi(xs[qq]), b0 = s ? bf_lo(ys[qq]) : 0.f, b1 = s ? bf_hi(ys[qq]) : 0.f;
                ps[qq] = cvt_pk_bf16(a0 + b0, a1 + b1); ms[qq] = s ? cvt_pk_bf16(a0 - b0, a1 - b1) : 0u; }
            u32x4 wp, wm; wp.x = ps[0]; wp.y = ps[1]; wp.z = ps[2]; wp.w = ps[3]; wm.x = ms[0]; wm.y = ms[1]; wm.z = ms[2]; wm.w = ms[3];
            g8::stg16_wt(UF + (((size_t)b * 2 + 0) * 2048 + s) * D + c0, wp);
            g8::stg16_wt(UF + (((size_t)b * 2 + 1) * 2048 + s) * D + c0, wm); }
    }
    for (int it = F.gw; it < NB * D; it += F.NGW) {
        const int col = it & 1023, b = it >> 10, g = col >> 8, l = col & 255;
        const u32x2 uw = *(const u32x2*)(U + ((size_t)b * S + 2048) * D + g * 256 + 4 * F.lane); const int cq = 4 * F.lane;
        float acc = __builtin_amdgcn_cosf((float)((l * cq) & 255) * (1.f / 256.f)) * bf_lo(uw.x) + __builtin_amdgcn_cosf((float)((l * (cq + 1)) & 255) * (1.f / 256.f)) * bf_hi(uw.x)
                  + __builtin_amdgcn_cosf((float)((l * (cq + 2)) & 255) * (1.f / 256.f)) * bf_lo(uw.y) + __builtin_amdgcn_cosf((float)((l * (cq + 3)) & 255) * (1.f / 256.f)) * bf_hi(uw.y);
        acc = wave_sum(acc);
        bf16* o = PQ + (size_t)it * KSEQ + 1024;
        { u32x4 w; w.x = (F.lane == 0) ? cvt_pk_bf16(acc, 0.f) : 0u; w.y = 0u; w.z = 0u; w.w = 0u;
            *(u32x4*)(o + (size_t)(F.lane >> 4) * KQ + 8 * (F.lane & 15)) = w; }
    }
}

__device__ __forceinline__ void ft_unfold_pass(CTXA) {
    CTX_LOCAL();
    const bf16* CS = WSP(bf16, WS_Y); bf16* FO = WSP(bf16, WS_BUFC); const bf16* PQ = WSP(bf16, WS_LA);
    const size_t gt = (size_t)blockIdx.x * NTHREADS + F.tid, NGT = (size_t)F.G * NTHREADS;
    for (size_t i0 = gt; i0 < (size_t)NB * 1024 * (D / 8); i0 += 2 * NGT) {
        u32x4 in[2][4];
#pragma unroll
        for (int q = 0; q < 2; ++q) { const size_t i = i0 + q * NGT; const int c0 = (int)(i & 127) * 8, k = (int)(i >> 7) & 1023, b = (int)(i >> 17);
#pragma unroll
            for (int ty = 0; ty < 4; ++ty) in[q][ty] = *(const u32x4*)(CS + ((size_t)b * S + ty * 1024 + k) * D + c0); }
        asm volatile("" : "+v"(in[0][0]), "+v"(in[0][1]), "+v"(in[0][2]), "+v"(in[0][3]), "+v"(in[1][0]), "+v"(in[1][1]), "+v"(in[1][2]), "+v"(in[1][3]));
#pragma unroll
        for (int q = 0; q < 2; ++q) { const size_t i = i0 + q * NGT; const int c0 = (int)(i & 127) * 8, k = (int)(i >> 7) & 1023, b = (int)(i >> 17);
            const unsigned ec[4] = {in[q][0].x, in[q][0].y, in[q][0].z, in[q][0].w}, oc[4] = {in[q][1].x, in[q][1].y, in[q][1].z, in[q][1].w};
            const unsigned es[4] = {in[q][2].x, in[q][2].y, in[q][2].z, in[q][2].w}, os[4] = {in[q][3].x, in[q][3].y, in[q][3].z, in[q][3].w};
            unsigned f0[4], f1[4], f2[4], f3[4];
#pragma unroll
            for (int qq = 0; qq < 4; ++qq) {
                const float c1l = bf_lo(ec[qq]) + bf_lo(oc[qq]), c1h = bf_hi(ec[qq]) + bf_hi(oc[qq]), c2l = bf_lo(ec[qq]) - bf_lo(oc[qq]), c2h = bf_hi(ec[qq]) - bf_hi(oc[qq]);
                const float s1l = bf_lo(es[qq]) + bf_lo(os[qq]), s1h = bf_hi(es[qq]) + bf_hi(os[qq]), s2l = bf_lo(os[qq]) - bf_lo(es[qq]), s2h = bf_hi(os[qq]) - bf_hi(es[qq]);
                f0[qq] = cvt_pk_bf16(c1l - s1l, c1h - s1h); f1[qq] = cvt_pk_bf16(c1l + s1l, c1h + s1h); f2[qq] = cvt_pk_bf16(c2l - s2l, c2h - s2h); f3[qq] = cvt_pk_bf16(c2l + s2l, c2h + s2h); }
            g8::stg16_wt(FO + ((size_t)b * S + k) * D + c0, (u32x4){f0[0], f0[1], f0[2], f0[3]});
            g8::stg16_wt(FO + ((size_t)b * S + (2048 - k)) * D + c0, (u32x4){f2[0], f2[1], f2[2], f2[3]});
            if (k) { g8::stg16_wt(FO + ((size_t)b * S + (S - k)) * D + c0, (u32x4){f1[0], f1[1], f1[2], f1[3]});
                     g8::stg16_wt(FO + ((size_t)b * S + (2048 + k)) * D + c0, (u32x4){f3[0], f3[1], f3[2], f3[3]}); } }
    }
    for (int it = F.gw; it < NB * D; it += F.NGW) {
        const int col = it & 1023, b = it >> 10; const bf16* pr = PQ + (size_t)it * KSEQ; u32x4 pw[4];
        pw[0] = *(const u32x4*)(pr + 16 * F.lane); pw[1] = *(const u32x4*)(pr + 16 * F.lane + 8);
        pw[2] = *(const u32x4*)(pr + 3 * KQ + 16 * F.lane); pw[3] = *(const u32x4*)(pr + 3 * KQ + 16 * F.lane + 8);
        unsigned p2k = (unsigned)pr[1024];
        asm volatile("" : "+v"(pw[0]), "+v"(pw[1]), "+v"(pw[2]), "+v"(pw[3]), "+v"(p2k));
        float ac = 0.f, as = 0.f;
#pragma unroll
        for (int q = 0; q < 2; ++q) { const u32x4 w = pw[q], x = pw[2 + q];
            ac += (bf_lo(w.x) - bf_hi(w.x)) + (bf_lo(w.y) - bf_hi(w.y)) + (bf_lo(w.z) - bf_hi(w.z)) + (bf_lo(w.w) - bf_hi(w.w));
            as += (bf_lo(x.x) - bf_hi(x.x)) + (bf_lo(x.y) - bf_hi(x.y)) + (bf_lo(x.z) - bf_hi(x.z)) + (bf_lo(x.w) - bf_hi(x.w)); }
        ac = wave_sum(ac); as = wave_sum(as);
        if (F.lane == 0) { const float c = (ac + __uint_as_float(p2k << 16)) * (1.f / 1024.f), s = as * (1.f / 1024.f);
            FO[((size_t)b * S + 1024) * D + col] = (bf16)(cvt_pk_bf16(c - s, 0.f) & 0xffffu); FO[((size_t)b * S + 3072) * D + col] = (bf16)(cvt_pk_bf16(c + s, 0.f) & 0xffffu); }
    }
}

__device__ __forceinline__ void scan_s1(CTXA) {
    CTX_LOCAL();
    const bf16* LA = WSP(bf16, WS_LA); const bf16* BB = WSP(bf16, WS_BB); float* CA = WSP(float, WS_CA); float* CB = WSP(float, WS_CB);
    for (int it = F.gw; it < 2 * NB * 64 * 8; it += F.NGW) {
        const int cg = it & 7, chunk = (it >> 3) & 63, b = (it >> 9) & 3, d = it >> 11;
        const int ch = cg * 128 + 2 * F.lane;
        const size_t e0 = (size_t)d * T * D + ((size_t)b * S + chunk * 64) * D + ch;
        const unsigned* la = (const unsigned*)(LA + e0); const unsigned* bb = (const unsigned*)(BB + e0);
        float A0 = 0.f, A1 = 0.f, B0 = 0.f, B1 = 0.f;
#pragma unroll
        for (int g = 0; g < 4; ++g) { unsigned wl[16], wb[16];
#pragma unroll
            for (int q = 0; q < 16; ++q) { const int tt = g * 16 + q, t = d ? 63 - tt : tt; wl[q] = la[(size_t)t * (D / 2)]; wb[q] = bb[(size_t)t * (D / 2)]; }
#pragma unroll
            for (int q = 0; q < 16; ++q) { const float l0 = bf_lo(wl[q]), l1 = bf_hi(wl[q]);
                A0 += l0; A1 += l1; B0 = __expf(l0) * B0 + bf_lo(wb[q]); B1 = __expf(l1) * B1 + bf_hi(wb[q]); } }
        const size_t o = ((size_t)((d * NB + b) * 64 + chunk)) * D + ch;
        *(f32x2*)(CA + o) = (f32x2){A0, A1}; *(f32x2*)(CB + o) = (f32x2){B0, B1};
    }
}
__device__ __forceinline__ void scan_s3(CTXA) {
    CTX_LOCAL();
    const bf16* LA = WSP(bf16, WS_LA); const bf16* BB = WSP(bf16, WS_BB); const float* CA = WSP(float, WS_CA); const float* CB = WSP(float, WS_CB);
    const bf16* GG = WSP(bf16, WS_BUFA); bf16* Y = WSP(bf16, WS_Y);
    for (int it = F.gw; it < NB * 64 * 8; it += F.NGW) {
        const int cg = it & 7, chunk = (it >> 3) & 63, b = it >> 9;
        const int ch = cg * 128 + 2 * F.lane;
        float hf0 = 0.f, hf1 = 0.f, hb0 = 0.f, hb1 = 0.f;
        for (int c0 = 0; c0 < chunk; c0 += 16) { f32x2 av[16], bv[16];
#pragma unroll
            for (int q = 0; q < 16; ++q) { const int c = c0 + q; const bool ok = c < chunk; const size_t o = ((size_t)((0 * NB + b) * 64 + (ok ? c : 0))) * D + ch;
                av[q] = *(const f32x2*)(CA + o); bv[q] = *(const f32x2*)(CB + o); if (!ok) { av[q] = (f32x2){0.f, 0.f}; bv[q] = (f32x2){0.f, 0.f}; } }
#pragma unroll
            for (int q = 0; q < 16; ++q) { hf0 = __expf(av[q].x) * hf0 + bv[q].x; hf1 = __expf(av[q].y) * hf1 + bv[q].y; } }
        for (int c0 = 63; c0 > chunk; c0 -= 16) { f32x2 av[16], bv[16];
#pragma unroll
            for (int q = 0; q < 16; ++q) { const int c = c0 - q; const bool ok = c > chunk; const size_t o = ((size_t)((1 * NB + b) * 64 + (ok ? c : 63))) * D + ch;
                av[q] = *(const f32x2*)(CA + o); bv[q] = *(const f32x2*)(CB + o); if (!ok) { av[q] = (f32x2){0.f, 0.f}; bv[q] = (f32x2){0.f, 0.f}; } }
#pragma unroll
            for (int q = 0; q < 16; ++q) { hb0 = __expf(av[q].x) * hb0 + bv[q].x; hb1 = __expf(av[q].y) * hb1 + bv[q].y; } }
        const size_t e0 = ((size_t)b * S + chunk * 64) * D + ch;
        const unsigned* la0 = (const unsigned*)(LA + e0); const unsigned* bb0 = (const unsigned*)(BB + e0);
        const unsigned* la1 = (const unsigned*)(LA + (size_t)T * D + e0); const unsigned* bb1 = (const unsigned*)(BB + (size_t)T * D + e0);
        const unsigned* gg = (const unsigned*)(GG + e0); unsigned* yy = (unsigned*)(Y + e0);
        float fv0[64], fv1[64];
#pragma unroll
        for (int g = 0; g < 4; ++g) { unsigned wl[16], wb[16];
#pragma unroll
            for (int q = 0; q < 16; ++q) { const int t = g * 16 + q; wl[q] = la0[(size_t)t * (D / 2)]; wb[q] = bb0[(size_t)t * (D / 2)]; }
#pragma unroll
            for (int q = 0; q < 16; ++q) { const int t = g * 16 + q; hf0 = __expf(bf_lo(wl[q])) * hf0 + bf_lo(wb[q]); hf1 = __expf(bf_hi(wl[q])) * hf1 + bf_hi(wb[q]); fv0[t] = hf0; fv1[t] = hf1; } }
#pragma unroll
        for (int g = 0; g < 4; ++g) { unsigned wl[16], wb[16], wg[16];
#pragma unroll
            for (int q = 0; q < 16; ++q) { const int t = 63 - (g * 16 + q); wl[q] = la1[(size_t)t * (D / 2)]; wb[q] = bb1[(size_t)t * (D / 2)]; wg[q] = gg[(size_t)t * (D / 2)]; }
#pragma unroll
            for (int q = 0; q < 16; ++q) { const int t = 63 - (g * 16 + q); hb0 = __expf(bf_lo(wl[q])) * hb0 + bf_lo(wb[q]); hb1 = __expf(bf_hi(wl[q])) * hb1 + bf_hi(wb[q]);
                yy[(size_t)t * (D / 2)] = cvt_pk_bf16((fv0[t] + hb0) * bf_lo(wg[q]), (fv1[t] + hb1) * bf_hi(wg[q])); } }
    }
}

__device__ __forceinline__ void topk_pass(CTXA) {
    CTX_LOCAL();
    const float* AFF = WSP(float, WS_AFF); float* GATEV = WSP(float, WS_GATEV); int* SLOTOF = WSP(int, WS_SLOTOF);
    LAS unsigned* wcnt = (LAS unsigned*)F.lds;
    LAS unsigned* wtot = (LAS unsigned*)(F.lds + 256);
    int* IDX = WSP(int, WS_IDX);
    for (int pair = blockIdx.x; pair < NB * NE; pair += F.G) {
        const int b = pair >> 4, e = pair & 15;
        const float* aff = AFF + (size_t)pair * S + 8 * F.tid;
        const f32x4 v0 = *(const f32x4*)aff, v1 = *(const f32x4*)(aff + 4);
        float val[8] = {v0[0], v0[1], v0[2], v0[3], v1[0], v1[1], v1[2], v1[3]};
        unsigned key[8];
#pragma unroll
        for (int i = 0; i < 8; ++i) key[i] = __float_as_uint(val[i]);
        unsigned Tk = 0u; int par = 0;
        for (int bit = 30; bit >= 0; --bit) {
            const unsigned cand = Tk | (1u << bit); unsigned c = 0;
#pragma unroll
            for (int i = 0; i < 8; ++i) c += (unsigned)__builtin_popcountll(__ballot(key[i] >= cand));
            if (F.lane == 0) wcnt[par * 8 + F.wave] = c;
            __syncthreads();
            unsigned tot = 0;
#pragma unroll
            for (int w = 0; w < 8; ++w) tot += wcnt[par * 8 + w];
            if (tot >= (unsigned)CAP) Tk = cand;
            par ^= 1;
        }
        int gtc = 0, eqc = 0;
#pragma unroll
        for (int i = 0; i < 8; ++i) { gtc += key[i] > Tk; eqc += key[i] == Tk; }
        int gin = gtc, ein = eqc;
#pragma unroll
        for (int o = 1; o < 64; o <<= 1) { const int g2 = __shfl_up(gin, o), e2 = __shfl_up(ein, o); if (F.lane >= o) { gin += g2; ein += e2; } }
        if (F.lane == 63) { wtot[F.wave] = (unsigned)gin; wtot[8 + F.wave] = (unsigned)ein; }
        __syncthreads();
        int gb = gin - gtc, eb = ein - eqc, ngt = 0;
#pragma unroll
        for (int w = 0; w < 8; ++w) { const int g2 = (int)wtot[w], e2 = (int)wtot[8 + w]; ngt += g2; if (w < F.wave) { gb += g2; eb += e2; } }
        const int need_eq = CAP - ngt, slot0 = (e * NB + b) * CAP;
        int so[8];
#pragma unroll
        for (int i = 0; i < 8; ++i) { const bool g = key[i] > Tk, q = key[i] == Tk; const bool sel = g || (q && eb < need_eq); const int pos = gb + (eb < need_eq ? eb : need_eq);
            if (sel) { IDX[slot0 + pos] = 8 * F.tid + i; GATEV[slot0 + pos] = val[i]; }
            so[i] = sel ? pos : -1; gb += g; eb += q; }
        int* sp = SLOTOF + (size_t)pair * S + 8 * F.tid;
        *(int4*)sp = make_int4(so[0], so[1], so[2], so[3]); *(int4*)(sp + 4) = make_int4(so[4], so[5], so[6], so[7]);
        __syncthreads();
        __syncthreads();
    }
}


__device__ __forceinline__ void combine_pass(CTXA, int layer) {
    CTX_LOCAL();
    bf16* H = WSP(bf16, WS_HB); unsigned char* XN8 = WSP(unsigned char, WS_XN); const unsigned char* YG = WSP(unsigned char, WS_YG); const int* SLOTOF = WSP(int, WS_SLOTOF);
    const float* g = INP(4) + layer * D;
    f32x4 gv[4];
#pragma unroll
    for (int j = 0; j < 4; ++j) gv[j] = *(const f32x4*)(g + 4 * F.lane + 256 * j);
    const int vcu = F.gw / NWAVES, ntrip = ((T / 64 - vcu + F.G - 1) / F.G) * 4;
#define CMB_ROW(tp, rr) ((vcu + ((tp) >> 2) * F.G) * 64 + 8 * F.wave + 2 * ((tp) & 3) + (rr))
    int sln[2];
#pragma unroll
    for (int rr = 0; rr < 2; ++rr) { const int row = CMB_ROW(0, rr); sln[rr] = (ntrip > 0) ? SLOTOF[((size_t)((row >> 12) * NE + (F.lane & 15))) * S + (row & 4095)] : -1; }
    for (int tp = 0; tp < ntrip; ++tp) {
        int sl[2]; f32x4 v[2][4]; unsigned em[2]; unsigned yw[2][4][4]; float wgt[2][4];
#pragma unroll
        for (int rr = 0; rr < 2; ++rr) { const int row = CMB_ROW(tp, rr);
            sl[rr] = sln[rr]; { const int rown = CMB_ROW(tp + 1, rr); sln[rr] = (tp + 1 < ntrip) ? SLOTOF[((size_t)((rown >> 12) * NE + (F.lane & 15))) * S + (rown & 4095)] : -1; }
#pragma unroll
            for (int j = 0; j < 4; ++j) { const u32x2 w = *(const u32x2*)(H + (size_t)row * D + 4 * F.lane + 256 * j); v[rr][j] = (f32x4){bf_lo(w.x), bf_hi(w.x), bf_lo(w.y), bf_hi(w.y)}; } }
#pragma unroll
        for (int rr = 0; rr < 2; ++rr) { const int row = CMB_ROW(tp, rr), b = row >> 12;
            em[rr] = (unsigned)(__ballot(sl[rr] >= 0) & 0xFFFFull);
#pragma unroll
            for (int q = 0; q < 4; ++q) { const bool valid = em[rr] != 0u; const int e = valid ? __builtin_ctz(em[rr]) : 0; em[rr] &= em[rr] - 1u;
                const int se = __builtin_amdgcn_readlane(sl[rr], e); wgt[rr][q] = __builtin_ldexpf(valid ? 1.f : 0.f, -6);
                const unsigned char* y = YG + ((size_t)((e * NB + b) * CAP + (valid ? se : 0))) * D + 4 * F.lane;
#pragma unroll
                for (int j = 0; j < 4; ++j) yw[rr][q][j] = *(const unsigned*)(y + 256 * j); } }
#pragma unroll
        for (int rr = 0; rr < 2; ++rr) { const int row = CMB_ROW(tp, rr), b = row >> 12;
#pragma unroll
            for (int q = 0; q < 4; ++q)
#pragma unroll
                for (int j = 0; j < 4; ++j) { const int w = (int)yw[rr][q][j]; const float g1 = wgt[rr][q];
                    v[rr][j][0] += g1 * __builtin_amdgcn_cvt_f32_fp8(w, 0); v[rr][j][1] += g1 * __builtin_amdgcn_cvt_f32_fp8(w, 1); v[rr][j][2] += g1 * __builtin_amdgcn_cvt_f32_fp8(w, 2); v[rr][j][3] += g1 * __builtin_amdgcn_cvt_f32_fp8(w, 3); }
            unsigned m2 = em[rr];
            while (m2) { const int e = __builtin_ctz(m2); m2 &= m2 - 1u; const int se = __builtin_amdgcn_readlane(sl[rr], e);
                const unsigned char* y = YG + ((size_t)((e * NB + b) * CAP + se)) * D + 4 * F.lane;
#pragma unroll
                for (int j = 0; j < 4; ++j) { const int w = (int)*(const unsigned*)(y + 256 * j); const float g1 = 1.f / 64.f;
                    v[rr][j][0] += g1 * __builtin_amdgcn_cvt_f32_fp8(w, 0); v[rr][j][1] += g1 * __builtin_amdgcn_cvt_f32_fp8(w, 1); v[rr][j][2] += g1 * __builtin_amdgcn_cvt_f32_fp8(w, 2); v[rr][j][3] += g1 * __builtin_amdgcn_cvt_f32_fp8(w, 3); } }
            float ss = 0.f;
#pragma unroll
            for (int j = 0; j < 4; ++j) { u32x2 hw2; hw2.x = cvt_pk_bf16(v[rr][j][0], v[rr][j][1]); hw2.y = cvt_pk_bf16(v[rr][j][2], v[rr][j][3]); *(u32x2*)(H + (size_t)row * D + 4 * F.lane + 256 * j) = hw2; ss += (v[rr][j][0] * v[rr][j][0] + v[rr][j][1] * v[rr][j][1]) + (v[rr][j][2] * v[rr][j][2] + v[rr][j][3] * v[rr][j][3]); }
            const float rs = rsqrtf(wave_sum(ss) * (1.f / D) + EPS);
#pragma unroll
            for (int j = 0; j < 4; ++j) { const f32x4 o = v[rr][j] * rs * gv[j]; *(unsigned*)(XN8 + (size_t)row * D + 4 * F.lane + 256 * j) = pk4_fp8(clamp448(8.f * o[0]), clamp448(8.f * o[1]), clamp448(8.f * o[2]), clamp448(8.f * o[3])); } }
    }
#undef CMB_ROW
}

constexpr int PH_PER_LAYER = 16, PH_FINAL = 1 + DEPTH * PH_PER_LAYER, PH_END = PH_FINAL + 1;
__host__ __device__ inline bool phase_exists(int ph) {
    if (ph == 0 || ph == PH_FINAL) return true;
    if (ph < 0 || ph > PH_FINAL) return false;
    const int l = (ph - 1) / PH_PER_LAYER, k = (ph - 1) % PH_PER_LAYER;
    if (k >= 15 || k == 0) return false;
    if (k == 8) return false;
    if (k == 10) return false;

    return true;
}

__global__ void __launch_bounds__(NTHREADS, 2) mk_fwd(Args args) {
    extern __shared__ __attribute__((aligned(16))) unsigned char lds_raw[];
    LAS unsigned char* const lds = (LAS unsigned char*)lds_raw;
    volatile LAS unsigned* MISC = (volatile LAS unsigned*)(lds + MISC_OFF);
    for (int u = threadIdx.x; u < 256; u += NTHREADS) MISC[u] = 0u;
    __syncthreads();
    const int lo = args.ph_lo, hi = args.ph_hi;
    const bool multi = (hi - lo) > 1;
    const bool grp_ok = multi && gridDim.x == 256u; const int grp_id = (int)(((blockIdx.x & 7u) * 32u + (blockIdx.x >> 3)) >> 2); unsigned grp_uses = 0u;
    if (grp_ok && threadIdx.x == 0) __hip_atomic_store((unsigned*)(args.ws + WS_CTL) + CW_XID + ((blockIdx.x & 7u) * 32u + (blockIdx.x >> 3)), xb_xcc_id() + 1u, __ATOMIC_RELAXED, __HIP_MEMORY_SCOPE_AGENT);
    XcdBarrier bar; bar.bar = (unsigned*)(args.ws + WS_CTL) + CW_BAR; bar.x = 0; bar.st = MISC + 8;
    if (multi) bar = xcd_barrier_post((unsigned*)(args.ws + WS_CTL) + CW_BAR, MISC + 8);

#ifndef PROBE_REPEAT
#define PROBE_REPEAT(ph) 0
#endif
    for (int ph0 = lo, rep = 0; ph0 < hi; ) {
        const int ph = ph0;
        if (rep < PROBE_REPEAT(ph)) ++rep; else { rep = 0; ++ph0; }
        if (!phase_exists(ph)) continue;
        struct { int z; } F; F.z = opaque_zero();
        bool isg = false; g8::Desc gd;
        gd.kind = g8::K_PLAIN; gd.K = D; gd.lda = D; gd.ldb = D; gd.nM = 64; gd.nN = 4; gd.ldo = D; gd.esz = 2; gd.gidx = nullptr; gd.u0 = (int)blockIdx.x; gd.ustride = (int)gridDim.x; gd.grp = 0; gd.sc_w = 0x7F7F7F7F; gd.sc_a = 0x7F7F7F7F; gd.A = nullptr; gd.Bt = nullptr; gd.o0 = nullptr; gd.o1 = nullptr; gd.p0 = nullptr; gd.p1 = nullptr; gd.p2 = nullptr;
        if (ph == 0) p0_prologue(lds, args);
        else if (ph == PH_FINAL) final_pass(lds, args);
        else {
            const int layer = (ph - 1) / PH_PER_LAYER, k = (ph - 1) % PH_PER_LAYER, j = layer >> 1; const bool rg = (layer & 1) == 0;
            switch (k) {
            case 1: isg = true; gd.A = WSP(bf16, WS_HB); gd.grp = grp_ok ? 1 : 0;
                if (rg) { gd.kind = g8::K_RGIN; gd.nN = 8; gd.Bt = WSP(bf16, WS_WINT) + (size_t)j * 2048 * 1024; gd.p0 = INP(7) + (size_t)j * 2048; gd.p1 = WSP(float, WS_SSQ); gd.o0 = WSP(bf16, WS_BUFA); gd.o1 = WSP(bf16, WS_BUFB); }
                else { gd.Bt = WSP(bf16, WS_FTINT) + (size_t)j * 1048576; gd.p0 = WSP(float, WS_SSQ); gd.o0 = WSP(bf16, WS_BUFA); }
                break;
            case 2: if (rg) conv_pass(lds, args, j); else ft_fold_pass(lds, args); break;
            case 3: isg = true;
                if (rg) { gd.kind = g8::K_RGGATE; gd.grp = grp_ok ? 1 : 0; gd.K = 256; gd.lda = D; gd.ldb = 256; gd.nN = 16; gd.A = WSP(bf16, WS_BUFC); gd.Bt = WSP(bf16, WS_GATET) + (size_t)j * 4 * 1024 * 256;
                    gd.p0 = INP(11) + (size_t)j * 2048; gd.p1 = INP(13) + (size_t)j * 2048; gd.p2 = INP(14) + (size_t)j * 2048; gd.o0 = WSP(bf16, WS_LA); gd.o1 = WSP(bf16, WS_BB); }
                else { gd.kind = g8::K_FTCH; gd.K = 256; gd.lda = 256; gd.ldb = D; gd.nM = 32; gd.nN = 8; gd.ldo = KSEQ; gd.A = WSP(bf16, WS_DFTC); gd.Bt = WSP(bf16, WS_BUFB); gd.o0 = WSP(bf16, WS_LA); }
                break;
            case 4: if (rg) scan_s1(lds, args);
                else { isg = true; gd.kind = g8::K_FTSEQ; gd.K = KQ; gd.lda = KQ; gd.ldb = KSEQ; gd.A = WSP(bf16, WS_DFTS); gd.Bt = WSP(bf16, WS_LA); gd.o0 = WSP(bf16, WS_Y); }
                break;
            case 5: if (rg) scan_s3(lds, args); else ft_unfold_pass(lds, args); break;
            case 6: isg = true; gd.kind = g8::K_RESID; gd.o0 = WSP(bf16, WS_HB); gd.grp = grp_ok ? 1 : 0;
                if (rg) { gd.A = WSP(bf16, WS_Y); gd.Bt = WSP(bf16, WS_WOUTT) + (size_t)j * 1048576; gd.p0 = INP(16) + (size_t)j * D; }
                else { gd.A = WSP(bf16, WS_BUFC); gd.Bt = WSP(bf16, WS_FTOUTT) + (size_t)j * 1048576; }
                break;
            case 7: router_pass(lds, args, layer); break;
            case 9: topk_pass(lds, args);
                isg = true; gd.K = PLE; gd.lda = PLE; gd.ldb = PLE; gd.A = WSP(bf16, WS_PBF) + (size_t)layer * T * PLE; gd.Bt = WSP(bf16, WS_PLEPT) + (size_t)layer * 1024 * 256; gd.o0 = WSP(bf16, WS_PP) + (size_t)layer * T * D;
                { const int npair = NB * NE, G = (int)gridDim.x; if (G > npair) { gd.u0 = (int)blockIdx.x - npair; gd.ustride = G - npair; } }
                break;
            case 11: isg = true; gd.kind = g8::K_FFN1; gd.grp = grp_ok ? 1 : 0; gd.nM = 128; gd.nN = 16; gd.esz = 1; gd.sc_w = 0x76767676; gd.sc_a = 0x7C7C7C7C;
                gd.A = WSP(unsigned char, WS_XN); gd.gidx = WSP(int, WS_IDX); gd.Bt = WSP(unsigned char, WS_W1T) + (size_t)layer * NE * 4096 * 1024; gd.o0 = WSP(unsigned char, WS_HG); break;
            case 12: isg = true; gd.kind = g8::K_FFN2; gd.grp = grp_ok ? 1 : 0; gd.K = FF; gd.lda = FF; gd.ldb = FF; gd.nM = 128; gd.esz = 1; gd.sc_w = 0x76767676; gd.sc_a = 0x7D7D7D7D;
                gd.A = WSP(unsigned char, WS_HG); gd.Bt = WSP(unsigned char, WS_W2T) + (size_t)layer * NE * 1024 * 2048; gd.p0 = WSP(float, WS_GATEV); gd.o0 = WSP(unsigned char, WS_YG); break;
            case 13: combine_pass(lds, args, layer); break;
            case 14: isg = true; gd.kind = g8::K_PLE; gd.esz = 1; gd.grp = grp_ok ? 1 : 0; gd.sc_w = 0x76767676; gd.sc_a = 0x7C7C7C7C; gd.A = WSP(unsigned char, WS_XN); gd.Bt = WSP(unsigned char, WS_PLEGT) + (size_t)layer * 1048576; gd.p0 = WSP(bf16, WS_PP) + (size_t)layer * T * D; gd.p1 = WSP(float, WS_SSQ); gd.o0 = WSP(bf16, WS_HB); break;
            default: break;
            }
        }
        if (isg) { if (gd.esz == 1) g8::gemm_phase<true>(lds, gd); else g8::gemm_phase<false>(lds, gd); }
        if (multi && ph0 < hi) {
            const int kk = (ph >= 1 && ph < PH_FINAL) ? (ph - 1) % PH_PER_LAYER : -1;
            const bool rgl = (((ph - 1) / PH_PER_LAYER) & 1) == 0;
            if (grp_ok && (kk == 6 || kk == 11 || kk == 13 || kk == 14 || (rgl && (kk == 2 || kk == 3 || kk == 5)))) group_barrier((unsigned*)(args.ws + WS_CTL), grp_id, 4u * (++grp_uses), MISC + 12);
            else xcd_barrier(bar);
        }
    }
}

extern "C" void kernel_launch(void* const* d_in, const int* in_sizes, int n_in, void* d_out, int out_size, void* d_ws, size_t ws_size, hipStream_t stream) {
    static int grid = 0;
    if (grid == 0) {
        if (n_in != 25 || in_sizes[0] != T * D || out_size != T * D || ws_size < WS_END) {
            fprintf(stderr, "kernel_launch: unexpected shapes (n_in %d, in0 %d, out %d, ws %zu < %zu); nothing launched\n", n_in, n_in > 0 ? in_sizes[0] : -1, out_size, ws_size, (size_t)WS_END); grid = -1; return; }
        int dev = 0, cus = 0, per_cu = 0;
        if (hipGetDevice(&dev) != hipSuccess || hipDeviceGetAttribute(&cus, hipDeviceAttributeMultiprocessorCount, dev) != hipSuccess) { grid = -1; return; }
        if (hipFuncSetAttribute((const void*)mk_fwd, hipFuncAttributeMaxDynamicSharedMemorySize, LDS_BYTES) != hipSuccess) { fprintf(stderr, "kernel_launch: hipFuncSetAttribute failed\n"); grid = -1; return; }
        if (hipOccupancyMaxActiveBlocksPerMultiprocessor(&per_cu, (const void*)mk_fwd, NTHREADS, LDS_BYTES) != hipSuccess || per_cu < 1)
            fprintf(stderr, "kernel_launch: occupancy query reports %d workgroups per CU\n", per_cu);
        (void)hipGetLastError();
        grid = cus;
    }
    if (grid < 0) return;
    (void)hipMemsetAsync((char*)d_ws + WS_CTL, 0, CTL_ZERO_BYTES, stream);
    Args a{};
    for (int i = 0; i < 25; ++i) a.in[i] = (const float*)d_in[i];
    a.out = (float*)d_out; a.ws = (unsigned char*)d_ws;
#if MK_ONE_LAUNCH
    a.ph_lo = 0; a.ph_hi = PH_END;
    hipLaunchKernelGGL(mk_fwd, dim3(grid), dim3(NTHREADS), LDS_BYTES, stream, a);
#else
    for (int ph = 0; ph < PH_END; ++ph) {
        if (!phase_exists(ph)) continue;
        a.ph_lo = ph; a.ph_hi = ph + 1;
        hipLaunchKernelGGL(mk_fwd, dim3(grid), dim3(NTHREADS), LDS_BYTES, stream, a);
    }
#endif
}
```
